# Optimizing an MI355X kernel written in HIP

```python
import functools
import jax, jax.numpy as jnp
from jax import lax
import numpy as np

D_MODEL = 1024
BATCH = 1
SEQ = 16384
DEPTH = 2
DEC_BATCH = 128
DEC_SEQ = 1
PAST_LEN = 16384
PAGE_SIZE = 128

ATT_HEADS = 8
ATT_KV_HEADS = 2
ATT_HEAD_DIM = 64
ATT_GROUP = ATT_HEADS // ATT_KV_HEADS
ATT_WIDTH = ATT_HEADS * ATT_HEAD_DIM
ATT_KV_WIDTH = ATT_KV_HEADS * ATT_HEAD_DIM
WINDOW = 128
RET_HEADS = 4
RET_DK = 128
RET_DV = 256
RET_QK_WIDTH = RET_HEADS * RET_DK
RET_WIDTH = RET_HEADS * RET_DV
RET_CHUNK = 128
ROPE_THETA = 10000.0
ALPHA = (2.0 * DEPTH) ** 0.25
BETA = (8.0 * DEPTH) ** -0.25
LN_EPS = 1e-5
RMS_EPS = 1e-6
SPLITS = (ATT_WIDTH, ATT_KV_WIDTH, ATT_KV_WIDTH, ATT_WIDTH,
          RET_QK_WIDTH, RET_QK_WIDTH, RET_WIDTH, RET_WIDTH,
          D_MODEL, D_MODEL)
IN_COLS = sum(SPLITS)

kernel_name = "hybrid_swa_sink_retention_adaln_deepnorm_step"


def rope(x, pos):
    half = x.shape[-1] // 2
    freqs = ROPE_THETA ** (-jnp.arange(half, dtype=jnp.float32) / half)
    ang = pos.astype(jnp.float32)[:, None] * freqs[None, :]
    cos = jnp.cos(ang)[:, None, :]
    sin = jnp.sin(ang)[:, None, :]
    xf = x.astype(jnp.float32)
    x1, x2 = xf[..., :half], xf[..., half:]
    return jnp.concatenate([x1 * cos - x2 * sin, x2 * cos + x1 * sin], axis=-1).astype(x.dtype)


def layer_norm(x, g, b):
    xf = x.astype(jnp.float32)
    mu = xf.mean(-1, keepdims=True)
    var = jnp.square(xf - mu).mean(-1, keepdims=True)
    y = (xf - mu) * lax.rsqrt(var + LN_EPS) * g.astype(jnp.float32) + b.astype(jnp.float32)
    return y.astype(x.dtype)


def sink_attention(q, k, v, qpos, kpos, sinks):
    logits = jnp.einsum('...qhgd,...khd->...hgqk', q.astype(jnp.float32), k.astype(jnp.float32))
    logits = logits * (ATT_HEAD_DIM ** -0.5)
    delta = qpos[..., :, None] - kpos[..., None, :]
    allowed = (delta >= 0) & (delta <= WINDOW) & (kpos[..., None, :] >= 0)
    logits = jnp.where(allowed[..., None, None, :, :], logits, -jnp.inf)
    sink = sinks.astype(jnp.float32).reshape(ATT_KV_HEADS, ATT_GROUP, 1, 1)
    m = jnp.maximum(logits.max(-1, keepdims=True), sink)
    p = jnp.exp(logits - m)
    denom = p.sum(-1, keepdims=True) + jnp.exp(sink - m)
    o = jnp.einsum('...hgqk,...khd->...qhgd', p / denom, v.astype(jnp.float32))
    return o.astype(q.dtype)


def window_attention_prompt(q, k, v, sinks):
    B, L, H, d = q.shape
    nb = L // WINDOW
    qb = q.reshape(B, nb, WINDOW, ATT_KV_HEADS, ATT_GROUP, d)
    kb = k.reshape(B, nb, WINDOW, ATT_KV_HEADS, d)
    vb = v.reshape(B, nb, WINDOW, ATT_KV_HEADS, d)

    def with_prev(t):
        prev = jnp.concatenate([jnp.zeros_like(t[:, :1]), t[:, :-1]], axis=1)
        return jnp.concatenate([prev, t], axis=2)

    pos = jnp.arange(L).reshape(nb, WINDOW)
    kpos = jnp.concatenate([pos - WINDOW, pos], axis=1)
    o = sink_attention(qb, with_prev(kb), with_prev(vb), pos, kpos, sinks)
    return o.reshape(B, L, H * d), k[:, L - WINDOW:], v[:, L - WINDOW:]


def window_attention_sample(q, k, v, sinks, k_buf, v_buf):
    B, T, H, d = q.shape
    W = k_buf.shape[1]
    qg = q.reshape(B, T, ATT_KV_HEADS, ATT_GROUP, d)
    kc = jnp.concatenate([k_buf.astype(k.dtype), k], axis=1)
    vc = jnp.concatenate([v_buf.astype(v.dtype), v], axis=1)
    qpos = PAST_LEN + jnp.arange(T)
    kpos = jnp.concatenate([PAST_LEN - W + jnp.arange(W), qpos])
    o = sink_attention(qg, kc, vc, qpos, kpos, sinks)
    return o.reshape(B, T, H * d), kc[:, T:], vc[:, T:]


def retention(q, k, v, s0):
    B, L, H, dk = q.shape
    dv = v.shape[-1]
    C = RET_CHUNK if L % RET_CHUNK == 0 else L
    nc = L // C
    log_gamma = jnp.log(1.0 - 2.0 ** (-5.0 - jnp.arange(H, dtype=jnp.float32)))
    idx = jnp.arange(C, dtype=jnp.float32)
    diff = idx[:, None] - idx[None, :]
    dmask = jnp.where(diff >= 0, jnp.exp(jnp.maximum(diff, 0.0)[None] * log_gamma[:, None, None]), 0.0)
    q_dec = jnp.exp((idx + 1.0)[None, :, None] * log_gamma[:, None, None])
    k_dec = jnp.exp((C - 1.0 - idx)[None, :, None] * log_gamma[:, None, None])
    chunk_dec = jnp.exp(C * log_gamma)[:, None, None]

    def to_chunks(t):
        return t.astype(jnp.float32).reshape(B, nc, C, H, t.shape[-1]).transpose(1, 0, 3, 2, 4)

    def step(S, inp):
        qc, kc, vc = inp
        inner = jnp.einsum('bhid,bhjd->bhij', qc, kc) * dmask
        o = jnp.einsum('bhij,bhje->bhie', inner, vc) + jnp.einsum('bhid,bhde->bhie', qc * q_dec, S)
        S = S * chunk_dec + jnp.einsum('bhjd,bhje->bhde', kc * k_dec, vc)
        return S, o

    s_fin, o = lax.scan(step, s0.astype(jnp.float32), (to_chunks(q), to_chunks(k), to_chunks(v)))
    o = o.transpose(1, 0, 3, 2, 4).reshape(B, L, H, dv)
    return o, s_fin


def decoder_layer(x, c, pos, s0, attend, sinks, w_in, w_cond, b_cond, w_pa, w_pr, w_out, ln_g, ln_b):
    B, L, _ = x.shape
    mod = jax.nn.silu(c) @ w_cond + b_cond
    shift, scale, gate = jnp.split(mod, 3, axis=-1)
    h = x * (1.0 + scale[:, None, :]) + shift[:, None, :]
    parts = jnp.split(h @ w_in, np.cumsum(SPLITS)[:-1].tolist(), axis=-1)
    aq, ak, av, ag, rq, rk, rv, rg, mga, mgr = parts
    q = rope(aq.reshape(B, L, ATT_HEADS, ATT_HEAD_DIM), pos)
    k = rope(ak.reshape(B, L, ATT_KV_HEADS, ATT_HEAD_DIM), pos)
    v = av.reshape(B, L, ATT_KV_HEADS, ATT_HEAD_DIM)
    o_att, k_new, v_new = attend(q, k, v, sinks)
    q_r = rope(rq.reshape(B, L, RET_HEADS, RET_DK), pos)
    k_r = rope(rk.reshape(B, L, RET_HEADS, RET_DK), pos) * (RET_DK ** -0.5)
    v_r = rv.reshape(B, L, RET_HEADS, RET_DV)
    o_ret, s_new = retention(q_r, k_r, v_r, s0)
    o_ret = o_ret * lax.rsqrt(jnp.square(o_ret).mean(-1, keepdims=True) + RMS_EPS)
    o_ret = o_ret.reshape(B, L, RET_WIDTH).astype(x.dtype)
    z_a = (o_att * jax.nn.silu(ag)) @ w_pa
    z_r = (o_ret * jax.nn.silu(rg)) @ w_pr
    z = jax.nn.sigmoid(mga) * z_a + jax.nn.sigmoid(mgr) * z_r
    y = layer_norm(ALPHA * x + gate[:, None, :] * (z @ w_out), ln_g, ln_b)
    return y, k_new, v_new, s_new


def setup_inputs(seed: int = 0) -> dict:
    key = jax.random.key(seed)
    ks = jax.random.split(key, 18)

    def nrm(k, shape, s):
        return jax.random.normal(k, shape, jnp.float32) * s

    win = min(WINDOW, PAST_LEN)
    return {
        "x_prompt": nrm(ks[0], (BATCH, SEQ, D_MODEL), 1.0),
        "x_sample": nrm(ks[1], (DEC_BATCH, DEC_SEQ, D_MODEL), 1.0),
        "c_prompt": nrm(ks[2], (BATCH, D_MODEL), 1.0),
        "c_sample": nrm(ks[3], (DEC_BATCH, D_MODEL), 1.0),
        "cache_k": nrm(ks[4], (DEPTH, DEC_BATCH, win, ATT_KV_HEADS, ATT_HEAD_DIM), 1.0),
        "cache_v": nrm(ks[5], (DEPTH, DEC_BATCH, win, ATT_KV_HEADS, ATT_HEAD_DIM), 1.0),
        "state_ret": nrm(ks[6], (DEPTH, DEC_BATCH, RET_HEADS, RET_DK, RET_DV), 0.1),
        "w_in": nrm(ks[7], (DEPTH, D_MODEL, IN_COLS), D_MODEL ** -0.5),
        "attn_sinks": nrm(ks[8], (DEPTH, ATT_HEADS), 1.0),
        "w_cond": nrm(ks[9], (DEPTH, D_MODEL, 3 * D_MODEL), D_MODEL ** -0.5),
        "b_cond": nrm(ks[10], (DEPTH, 3 * D_MODEL), 0.02),
        "w_proj_attn": nrm(ks[11], (DEPTH, ATT_WIDTH, D_MODEL), BETA * ATT_WIDTH ** -0.5),
        "w_proj_ret": nrm(ks[12], (DEPTH, RET_WIDTH, D_MODEL), BETA * RET_WIDTH ** -0.5),
        "w_out": nrm(ks[13], (DEPTH, D_MODEL, D_MODEL), BETA * D_MODEL ** -0.5),
        "ln_g": 1.0 + nrm(ks[14], (DEPTH, D_MODEL), 0.05),
        "ln_b": nrm(ks[15], (DEPTH, D_MODEL), 0.02),
    }


def reference(x_prompt, x_sample, c_prompt, c_sample, cache_k, cache_v, state_ret,
              w_in, attn_sinks, w_cond, b_cond, w_proj_attn, w_proj_ret, w_out, ln_g, ln_b):
    B, L, _ = x_prompt.shape
    DB, T, _ = x_sample.shape
    pos_prompt = jnp.arange(L)
    pos_sample = PAST_LEN + jnp.arange(T)
    s_zero = jnp.zeros((B, RET_HEADS, RET_DK, RET_DV), jnp.float32)
    yp, ys = x_prompt, x_sample
    kp, vp, sp, ksm, vsm, ssm = [], [], [], [], [], []
    for l in range(DEPTH):
        yp, k_new, v_new, s_new = decoder_layer(
            yp, c_prompt, pos_prompt, s_zero, window_attention_prompt, attn_sinks[l],
            w_in[l], w_cond[l], b_cond[l], w_proj_attn[l], w_proj_ret[l], w_out[l], ln_g[l], ln_b[l])
        kp.append(k_new)
        vp.append(v_new)
        sp.append(s_new.astype(x_prompt.dtype))
        attend_sample = functools.partial(window_attention_sample, k_buf=cache_k[l], v_buf=cache_v[l])
        ys, k_new, v_new, s_new = decoder_layer(
            ys, c_sample, pos_sample, state_ret[l], attend_sample, attn_sinks[l],
            w_in[l], w_cond[l], b_cond[l], w_proj_attn[l], w_proj_ret[l], w_out[l], ln_g[l], ln_b[l])
        ksm.append(k_new.astype(cache_k.dtype))
        vsm.append(v_new.astype(cache_v.dtype))
        ssm.append(s_new.astype(state_ret.dtype))
    return (yp, ys, jnp.stack(kp), jnp.stack(vp), jnp.stack(sp), jnp.stack(ksm), jnp.stack(vsm), jnp.stack(ssm))
```

```cpp
#include <hip/hip_runtime.h>
#include <hip/hip_cooperative_groups.h>
#include <cstdio>
namespace cg = cooperative_groups;
namespace pg8 {
#define PG8_LAS __attribute__((address_space(3)))
typedef unsigned short bf16_t;
typedef short bf16x8 __attribute__((ext_vector_type(8)));
typedef float f32x4 __attribute__((ext_vector_type(4)));
typedef unsigned u32x4 __attribute__((ext_vector_type(4)));
constexpr int BM = 256, BK = 64, HALF = 128, HTB = HALF * BK * 2  , STAGE_BYTES = 8 * HTB, NXCD = 8, WGM = 8;

__host__ __device__ __forceinline__ int lds_byte(int r, int c) { const int st = (r >> 4) * 2 + (c >> 5), rr = r & 15, cc = c & 31, ob = rr * 64 + cc * 2; return st * 1024 + (ob ^ (((ob >> 9) & 1) << 5)); }
__host__ __device__ __forceinline__ void stage_rc(int b, int& R, int& C) { const int st = b / 1024, sb = b % 1024, swz = sb ^ (((sb >> 9) & 1) << 5); R = (st >> 1) * 16 + swz / 64; C = (st & 1) * 32 + (swz % 64) / 2; }
__host__ __device__ __forceinline__ int perm32(int rho) { const int n = rho >> 4, i = rho & 15; return 8 * (i >> 2) + 4 * n + (i & 3); }

struct Unit { int pm, pn; };
struct Gemm { const bf16_t* A; const bf16_t* Bt; int M, N, K; };

struct StaticOrder {
    int nM, nN, nwg, G, c;
    __host__ __device__ void init(int M, int N, int G_, int c_) { nM = M / BM; nN = N / BM; nwg = nM * nN; G = G_; c = c_; }
    __host__ __device__ bool next(int i, Unit& u) const {
        const long L = (long)i * G + c; if (L >= nwg) return false;
        int wgid = (int)L; { const int q = nwg / NXCD, r = nwg % NXCD, xcd = wgid % NXCD, off = wgid / NXCD; wgid = (xcd < r ? xcd * (q + 1) : r * (q + 1) + (xcd - r) * q) + off; }
        const int nig = WGM * nN, gid = wgid / nig, fm = gid * WGM, gsz = (nM - fm) < WGM ? (nM - fm) : WGM;
        u.pm = fm + ((wgid % nig) % gsz); u.pn = (wgid % nig) / gsz; return true;
    }
    __device__ __forceinline__ void a_ready(const Unit&) const {}
    __device__ __forceinline__ void done(const Unit&) const {}
};
__device__ __forceinline__ unsigned cvt_pk_bf16(float lo, float hi) { unsigned r; asm volatile("v_cvt_pk_bf16_f32 %0, %1, %2" : "=v"(r) : "v"(lo), "v"(hi)); return r; }
struct EpiF32 {
    static constexpr bool PERM = false, AFTER_DRAIN = false;
    float* C; int ldc; const float* bias;
    __device__ __forceinline__ void operator()(const f32x4 (&acc)[2][2][4][2], const Unit& u, int wr, int wc, int fr, int fq) const {
        const int row0 = u.pm * BM + wr * 64 + fr, col0 = u.pn * BM + wc * 32 + 4 * fq;
        f32x4 bv[2][2];
#pragma unroll
        for (int bj = 0; bj < 2; ++bj)
#pragma unroll
            for (int n = 0; n < 2; ++n) bv[bj][n] = bias ? *(const f32x4*)(bias + col0 + bj * HALF + n * 16) : (f32x4){0.f, 0.f, 0.f, 0.f};
#pragma unroll
        for (int ai = 0; ai < 2; ++ai)
#pragma unroll
            for (int m = 0; m < 4; ++m) { float* rowp = C + (size_t)(row0 + ai * HALF + m * 16) * ldc + col0;
#pragma unroll
                for (int bj = 0; bj < 2; ++bj)
#pragma unroll
                    for (int n = 0; n < 2; ++n) *(f32x4*)(rowp + bj * HALF + n * 16) = acc[ai][bj][m][n] + bv[bj][n]; }
    }
};
template <class Epi, class Sched, bool STAMP = false>
__device__ __forceinline__ void gemm_phase(PG8_LAS unsigned char* lds, const Gemm g, const Sched& S, const Epi& E, unsigned long long* stamps) {
    int tid_ = threadIdx.x; asm volatile("" : "+v"(tid_)); const int tid = tid_, wid = __builtin_amdgcn_readfirstlane(tid >> 6), lane = tid & 63, wr = wid >> 2, wc = wid & 3, fr = lane & 15, fq = lane >> 4;
    const int K = g.K, nt = K / BK;
    int ts_lo = 0, ts_hi = 0, nts = 0; const unsigned long long rt_entry = STAMP ? (unsigned long long)wall_clock64() : 0ull;
#define PG8_STAMP() do { if (STAMP && wid == 0 && nts < 64) { const unsigned long long _c = (unsigned long long)clock64(); \
        ts_lo = (lane == nts) ? (int)(unsigned)_c : ts_lo; ts_hi = (lane == nts) ? (int)(unsigned)(_c >> 32) : ts_hi; ++nts; } } while (0)
    PG8_STAMP();
    unsigned voffA[2], voffB[2];
#pragma unroll
    for (int i = 0; i < 2; ++i) { int R, C; stage_rc(tid * 16 + i * 8192, R, C); const int Rb = Epi::PERM ? ((R & ~31) + perm32(R & 31)) : R;
        voffA[i] = (unsigned)(R * K + C) * 2u; voffB[i] = (unsigned)(Rb * K + C) * 2u; }
    const size_t kstep = (size_t)(BK * 2);
    const size_t hstep = (size_t)HALF * K * 2;
    const size_t tstep = 2 * hstep;
    const unsigned ldsw = (unsigned)wid * 1024u;
    const int aoff = lds_byte(wr * 64 + fr, fq * 8), boff = lds_byte(wc * 32 + fr, fq * 8);
#define PG8_SA(b, h) (((b) * 2 + (h)) * HTB)
#define PG8_SB(b, h) ((4 + (b) * 2 + (h)) * HTB)
#define PG8_STAGE(bufoff, gbase, voff) do { _Pragma("unroll") for (int _i = 0; _i < 2; ++_i) \
        __builtin_amdgcn_global_load_lds((const unsigned*)((const char*)(gbase) + (voff)[_i]), (PG8_LAS unsigned*)(lds + (bufoff) + ldsw + _i * 8192), 16, 0, 0); } while (0)
#define PG8_LDA(dst, b, h) do { _Pragma("unroll") for (int m = 0; m < 4; ++m) _Pragma("unroll") for (int k = 0; k < 2; ++k) dst[m][k] = *(const PG8_LAS bf16x8*)(lds + PG8_SA(b, h) + aoff + m * 2048 + k * 1024); } while (0)
#define PG8_LDB(dst, b, h) do { _Pragma("unroll") for (int n = 0; n < 2; ++n) _Pragma("unroll") for (int k = 0; k < 2; ++k) dst[n][k] = *(const PG8_LAS bf16x8*)(lds + PG8_SB(b, h) + boff + n * 2048 + k * 1024); } while (0)
#define PG8_MMA(ai, bj, At, Bt) do { __builtin_amdgcn_s_setprio(1); _Pragma("unroll") for (int m = 0; m < 4; ++m) _Pragma("unroll") for (int n = 0; n < 2; ++n) _Pragma("unroll") for (int k = 0; k < 2; ++k) \
        acc[ai][bj][m][n] = __builtin_amdgcn_mfma_f32_16x16x32_bf16(Bt[n][k], At[m][k], acc[ai][bj][m][n], 0, 0, 0); __builtin_amdgcn_s_setprio(0); } while (0)
#define PG8_WAIT_V(n) asm volatile("s_waitcnt vmcnt(" #n ")" ::: "memory")
#define PG8_WAIT_L(n) asm volatile("s_waitcnt lgkmcnt(" #n ")" ::: "memory")
#define PG8_BAR __builtin_amdgcn_s_barrier()
#define PG8_SCHED __builtin_amdgcn_sched_barrier(0)
    Unit cur, nxt; int ui = 0;
    if (!S.next(0, cur)) return;
    f32x4 acc[2][2][4][2];
#pragma unroll
    for (int a = 0; a < 2; ++a)
#pragma unroll
        for (int b = 0; b < 2; ++b)
#pragma unroll
            for (int m = 0; m < 4; ++m)
#pragma unroll
                for (int n = 0; n < 2; ++n) acc[a][b][m][n] = (f32x4){0.f, 0.f, 0.f, 0.f};
    bf16x8 At[4][2], B0[2][2], B1[2][2];
    const char* cA = (const char*)g.A + (size_t)cur.pm * tstep; const char* cB = (const char*)g.Bt + (size_t)cur.pn * tstep;
    S.a_ready(cur);
    PG8_STAGE(PG8_SB(0, 0), cB, voffB); PG8_STAGE(PG8_SA(0, 0), cA, voffA); PG8_STAGE(PG8_SB(0, 1), cB + hstep, voffB); PG8_STAGE(PG8_SA(0, 1), cA + hstep, voffA);
    if (wr == 1) PG8_BAR;
    PG8_WAIT_V(4); PG8_BAR;
    PG8_STAGE(PG8_SB(1, 0), cB + kstep, voffB); PG8_STAGE(PG8_SA(1, 0), cA + kstep, voffA); PG8_STAGE(PG8_SB(1, 1), cB + hstep + kstep, voffB);
    PG8_WAIT_V(6); PG8_BAR;
    PG8_STAMP();
    for (;;) {
        const bool has_next = S.next(ui + 1, nxt);
        const char* nA = has_next ? (const char*)g.A + (size_t)nxt.pm * tstep : cA; const char* nB = has_next ? (const char*)g.Bt + (size_t)nxt.pn * tstep : cB;
        for (int t = 0; t < nt; t += 2) {
            const bool last = (t == nt - 2);
            const char* a1 = cA + (size_t)(t + 1) * kstep;
            const char* a2 = last ? nA : cA + (size_t)(t + 2) * kstep; const char* b2 = last ? nB : cB + (size_t)(t + 2) * kstep;
            const char* a3 = a2 + kstep; const char* b3 = b2 + kstep;
            if (last && has_next) S.a_ready(nxt);
            PG8_LDB(B0, 0, 0); PG8_SCHED; PG8_LDA(At, 0, 0); PG8_STAGE(PG8_SA(1, 1), a1 + hstep, voffA);
            PG8_WAIT_L(8); PG8_BAR; PG8_WAIT_L(0); PG8_MMA(0, 0, At, B0); PG8_BAR; PG8_SCHED;
            PG8_LDB(B1, 0, 1); PG8_STAGE(PG8_SB(0, 0), b2, voffB);
            PG8_BAR; PG8_WAIT_L(0); PG8_MMA(0, 1, At, B1); PG8_BAR;
            PG8_LDA(At, 0, 1); PG8_STAGE(PG8_SA(0, 0), a2, voffA);
            PG8_BAR; PG8_WAIT_L(0); PG8_MMA(1, 0, At, B0); PG8_BAR; PG8_SCHED;
            PG8_STAGE(PG8_SB(0, 1), b2 + hstep, voffB);
            PG8_WAIT_V(6); PG8_BAR; PG8_MMA(1, 1, At, B1); PG8_BAR;
            PG8_LDB(B0, 1, 0); PG8_SCHED; PG8_LDA(At, 1, 0); PG8_STAGE(PG8_SA(0, 1), a2 + hstep, voffA);
            PG8_WAIT_L(8); PG8_BAR; PG8_WAIT_L(0); PG8_MMA(0, 0, At, B0); PG8_BAR; PG8_SCHED;
            PG8_LDB(B1, 1, 1); PG8_STAGE(PG8_SB(1, 0), b3, voffB);
            PG8_BAR; PG8_WAIT_L(0); PG8_MMA(0, 1, At, B1); PG8_BAR;
            PG8_LDA(At, 1, 1); PG8_STAGE(PG8_SA(1, 0), a3, voffA);
            PG8_BAR; PG8_WAIT_L(0); PG8_MMA(1, 0, At, B0); PG8_BAR; PG8_SCHED;
            PG8_STAGE(PG8_SB(1, 1), b3 + hstep, voffB);
            PG8_WAIT_V(6); PG8_BAR; PG8_MMA(1, 1, At, B1); PG8_BAR;
        }
        PG8_STAMP();
        if constexpr (!Epi::AFTER_DRAIN) { E(acc, cur, wr, wc, fr, fq); S.done(cur); }
        PG8_STAMP();
        if (!has_next) break;
#pragma unroll
        for (int a = 0; a < 2; ++a)
#pragma unroll
            for (int b = 0; b < 2; ++b)
#pragma unroll
                for (int m = 0; m < 4; ++m)
#pragma unroll
                    for (int n = 0; n < 2; ++n) acc[a][b][m][n] = (f32x4){0.f, 0.f, 0.f, 0.f};
        cur = nxt; cA = nA; cB = nB; ++ui;
    }
    PG8_WAIT_V(0);
    if (wr == 0) PG8_BAR;
    PG8_BAR;
    if constexpr (Epi::AFTER_DRAIN) { E.fused(acc, cur, wr, wc, fr, fq, lds, wid, lane); S.done(cur); }
    PG8_STAMP();
    if (STAMP && wid == 0) { stamps[lane] = lane < nts ? (((unsigned long long)(unsigned)ts_hi << 32) | (unsigned)ts_lo) : 0ull;
        if (lane == 62) stamps[62] = rt_entry; if (lane == 63) stamps[63] = (unsigned long long)wall_clock64(); }
#undef PG8_STAMP
#undef PG8_SA
#undef PG8_SB
#undef PG8_STAGE
#undef PG8_LDA
#undef PG8_LDB
#undef PG8_MMA
#undef PG8_WAIT_V
#undef PG8_WAIT_L
#undef PG8_BAR
#undef PG8_SCHED
}
}

using pg8::bf16_t; using pg8::bf16x8; using pg8::f32x4; using pg8::u32x4; using pg8::Unit; using pg8::Gemm; using pg8::StaticOrder; using pg8::cvt_pk_bf16;
typedef unsigned u32x2 __attribute__((ext_vector_type(2)));
typedef short bf16x4 __attribute__((ext_vector_type(4)));

constexpr int DM = 1024, LP = 16384, NSMP = 128, MREAL = LP + NSMP, MPAD = 16640, NIN = 6400, NLAYER = 2;
constexpr float ALPHA_F = 1.41421356237309515f;
constexpr int LDS_BYTES = 131072;
constexpr size_t al256(size_t x) { return (x + 255) & ~(size_t)255; }
constexpr size_t WS_WIN = 0;
constexpr size_t WS_WC = WS_WIN + al256((size_t)NLAYER * NIN * DM * 2);
constexpr size_t WS_WPA = WS_WC + al256((size_t)NLAYER * 3072 * DM * 2);
constexpr size_t WS_WPR = WS_WPA + al256((size_t)NLAYER * 1024 * 512 * 2);
constexpr size_t WS_WOUT = WS_WPR + al256((size_t)NLAYER * 1024 * 1024 * 2);
constexpr size_t WS_ACOND = WS_WOUT + al256((size_t)NLAYER * 1024 * 1024 * 2);
constexpr size_t WS_MOD = WS_ACOND + al256((size_t)256 * 1024 * 2);
constexpr size_t WS_ROPEA = WS_MOD + al256((size_t)256 * 6144 * 4);
constexpr size_t WS_ROPER = WS_ROPEA + al256((size_t)16385 * 32 * 8);
constexpr size_t WS_H = WS_ROPER + al256((size_t)16385 * 64 * 8);
constexpr size_t WS_X1 = WS_H + al256((size_t)MPAD * 1024 * 2);
constexpr size_t WS_QA = WS_X1 + al256((size_t)MREAL * 1024 * 4);
constexpr size_t WS_KA = WS_QA + al256((size_t)MPAD * 512 * 2);
constexpr size_t WS_VA = WS_KA + al256((size_t)MPAD * 128 * 2);
constexpr size_t WS_GA = WS_VA + al256((size_t)MPAD * 128 * 2);
constexpr size_t WS_QR = WS_GA + al256((size_t)MPAD * 512 * 2);
constexpr size_t WS_KR = WS_QR + al256((size_t)MPAD * 512 * 2);
constexpr size_t WS_VR = WS_KR + al256((size_t)MPAD * 512 * 2);
constexpr size_t WS_GR = WS_VR + al256((size_t)MPAD * 1024 * 2);
constexpr size_t WS_MG = WS_GR + al256((size_t)MPAD * 1024 * 2);
constexpr size_t WS_UT = WS_MG + al256((size_t)MPAD * 2048 * 2);
constexpr size_t WS_ST = WS_UT + al256((size_t)128 * 4 * 256 * 128 * 4);
constexpr size_t WS_END = WS_ST + al256((size_t)128 * 4 * 256 * 128 * 2);
constexpr size_t O_YP = 0, O_YS = O_YP + (size_t)LP * DM, O_NKP = O_YS + (size_t)NSMP * DM, O_NVP = O_NKP + 32768, O_NSP = O_NVP + 32768,
                 O_NKS = O_NSP + 262144, O_NVS = O_NKS + 4194304, O_NSS = O_NVS + 4194304, O_END = O_NSS + 33554432;

struct Params {
    const float *x_prompt, *x_sample, *c_prompt, *c_sample, *cache_k, *cache_v, *state_ret, *w_in, *sinks, *w_cond, *b_cond, *w_pa, *w_pr, *w_out, *ln_g, *ln_b;
    float* out; unsigned char* ws;
};

__device__ __forceinline__ int opq(int x) { asm volatile("" : "+v"(x)); return x; }
__device__ __forceinline__ float bf_lo(unsigned u) { return __uint_as_float(u << 16); }
__device__ __forceinline__ float bf_hi(unsigned u) { return __uint_as_float(u & 0xffff0000u); }
__device__ __forceinline__ float bf1(bf16_t b) { return __uint_as_float(((unsigned)b) << 16); }
__device__ __forceinline__ f32x4 mfma16(bf16x8 a, bf16x8 b, f32x4 c) { return __builtin_amdgcn_mfma_f32_16x16x32_bf16(a, b, c, 0, 0, 0); }
__device__ __forceinline__ float sigmoidf_(float x) { return __builtin_amdgcn_rcpf(1.0f + __expf(-x)); }
__device__ __forceinline__ float log2gamma(int h) { return __log2f(1.0f - exp2f(-5.0f - (float)h)); }
__device__ __forceinline__ bf16x8 pack8(f32x4 a, f32x4 b) {
    u32x4 r; r.x = cvt_pk_bf16(a[0], a[1]); r.y = cvt_pk_bf16(a[2], a[3]); r.z = cvt_pk_bf16(b[0], b[1]); r.w = cvt_pk_bf16(b[2], b[3]);
    return __builtin_bit_cast(bf16x8, r);
}
__device__ __forceinline__ bf16x8 cat44(bf16x4 a, bf16x4 b) { return __builtin_shufflevector(a, b, 0, 1, 2, 3, 4, 5, 6, 7); }

struct EpiIn {
    static constexpr bool PERM = true, AFTER_DRAIN = false;
    int layer; unsigned char* ws; float* out;
    __device__ __forceinline__ void operator()(const f32x4 (&acc)[2][2][4][2], const Unit& u, int wr, int wc, int fr, int fq) const {
        const int pn = u.pn; const int row0 = u.pm * 256 + wr * 64 + fr;
        const bool ropeA = (pn <= 1) || (pn == 2 && wc < 2), ropeR = (pn >= 5 && pn <= 8);
        if (ropeA || ropeR) {
            bf16_t* dst; int ld, c1, part; float sc; const float* tab; int tld;
            if (ropeA) { tab = (const float*)(ws + WS_ROPEA) + 2 * (8 * fq); tld = 64; part = 32;
                if (pn <= 1) { dst = (bf16_t*)(ws + WS_QA); ld = 512; c1 = pn * 256 + wc * 64 + 8 * fq; sc = 0.125f; }
                else { dst = (bf16_t*)(ws + WS_KA); ld = 128; c1 = wc * 64 + 8 * fq; sc = 1.0f; } }
            else { tab = (const float*)(ws + WS_ROPER) + 2 * (32 * (wc & 1) + 8 * fq); tld = 128; part = 64;
                if (pn <= 6) { dst = (bf16_t*)(ws + WS_QR); ld = 512; c1 = (pn - 5) * 256 + (wc >> 1) * 128 + (wc & 1) * 32 + 8 * fq; sc = 1.0f; }
                else { dst = (bf16_t*)(ws + WS_KR); ld = 512; c1 = (pn - 7) * 256 + (wc >> 1) * 128 + (wc & 1) * 32 + 8 * fq; sc = 0.08838834764831845f; } }
            const bool isk = (pn == 2);
#pragma unroll
            for (int ai = 0; ai < 2; ++ai)
#pragma unroll
                for (int m = 0; m < 4; ++m) {
                    const int r = row0 + ai * 128 + m * 16; const int pos = r < LP ? r : LP;
                    const f32x4* tp = (const f32x4*)(tab + (size_t)pos * tld);
                    f32x4 o1[2], o2[2];
#pragma unroll
                    for (int n = 0; n < 2; ++n) { const f32x4 t0 = tp[2 * n], t1 = tp[2 * n + 1];
                        const f32x4 x1 = acc[ai][0][m][n], x2 = acc[ai][1][m][n];
                        const float cs[4] = {t0[0], t0[2], t1[0], t1[2]}, sn[4] = {t0[1], t0[3], t1[1], t1[3]};
#pragma unroll
                        for (int e = 0; e < 4; ++e) { o1[n][e] = (x1[e] * cs[e] - x2[e] * sn[e]) * sc; o2[n][e] = (x2[e] * cs[e] + x1[e] * sn[e]) * sc; } }
                    u32x4 w1, w2; w1.x = cvt_pk_bf16(o1[0][0], o1[0][1]); w1.y = cvt_pk_bf16(o1[0][2], o1[0][3]); w1.z = cvt_pk_bf16(o1[1][0], o1[1][1]); w1.w = cvt_pk_bf16(o1[1][2], o1[1][3]);
                    w2.x = cvt_pk_bf16(o2[0][0], o2[0][1]); w2.y = cvt_pk_bf16(o2[0][2], o2[0][3]); w2.z = cvt_pk_bf16(o2[1][0], o2[1][1]); w2.w = cvt_pk_bf16(o2[1][2], o2[1][3]);
                    *(u32x4*)(dst + (size_t)r * ld + c1) = w1; *(u32x4*)(dst + (size_t)r * ld + c1 + part) = w2;
                    if (isk && r >= LP - 128 && r < MREAL) {
                        float* fo = (r < LP) ? out + O_NKP + (size_t)layer * 16384 + (size_t)(r - (LP - 128)) * 128 + c1
                                             : out + O_NKS + ((size_t)(layer * 128 + (r - LP)) * 128 + 127) * 128 + c1;
                        *(f32x4*)(fo) = o1[0]; *(f32x4*)(fo + 4) = o1[1]; *(f32x4*)(fo + 32) = o2[0]; *(f32x4*)(fo + 36) = o2[1];
                    }
                }
        } else if (pn == 2) {
            bf16_t* dst = (bf16_t*)(ws + WS_VA);
#pragma unroll
            for (int ai = 0; ai < 2; ++ai)
#pragma unroll
                for (int m = 0; m < 4; ++m) { const int r = row0 + ai * 128 + m * 16;
#pragma unroll
                    for (int bj = 0; bj < 2; ++bj) { const int c = bj * 64 + 32 * (wc - 2) + 8 * fq; const f32x4 a0 = acc[ai][bj][m][0], a1 = acc[ai][bj][m][1];
                        u32x4 w; w.x = cvt_pk_bf16(a0[0], a0[1]); w.y = cvt_pk_bf16(a0[2], a0[3]); w.z = cvt_pk_bf16(a1[0], a1[1]); w.w = cvt_pk_bf16(a1[2], a1[3]);
                        *(u32x4*)(dst + (size_t)r * 128 + c) = w;
                        if (r >= LP - 128 && r < MREAL) {
                            float* fo = (r < LP) ? out + O_NVP + (size_t)layer * 16384 + (size_t)(r - (LP - 128)) * 128 + c
                                                 : out + O_NVS + ((size_t)(layer * 128 + (r - LP)) * 128 + 127) * 128 + c;
                            *(f32x4*)(fo) = a0; *(f32x4*)(fo + 4) = a1; } } }
        } else {
            bf16_t* dst; int ld, cb, op;
            if (pn <= 4) { dst = (bf16_t*)(ws + WS_GA); ld = 512; cb = (pn - 3) * 256; op = 1; }
            else if (pn <= 12) { dst = (bf16_t*)(ws + WS_VR); ld = 1024; cb = (pn - 9) * 256; op = 0; }
            else if (pn <= 16) { dst = (bf16_t*)(ws + WS_GR); ld = 1024; cb = (pn - 13) * 256; op = 1; }
            else { dst = (bf16_t*)(ws + WS_MG); ld = 2048; cb = (pn - 17) * 256; op = 2; }
            cb += wc * 32 + 8 * fq;
#pragma unroll
            for (int ai = 0; ai < 2; ++ai)
#pragma unroll
                for (int m = 0; m < 4; ++m) { const int r = row0 + ai * 128 + m * 16;
#pragma unroll
                    for (int bj = 0; bj < 2; ++bj) { float v[8];
#pragma unroll
                        for (int e = 0; e < 8; ++e) { const float x = acc[ai][bj][m][e >> 2][e & 3]; const float s = sigmoidf_(x); v[e] = op == 0 ? x : (op == 1 ? x * s : s); }
                        u32x4 w; w.x = cvt_pk_bf16(v[0], v[1]); w.y = cvt_pk_bf16(v[2], v[3]); w.z = cvt_pk_bf16(v[4], v[5]); w.w = cvt_pk_bf16(v[6], v[7]);
                        *(u32x4*)(dst + (size_t)r * ld + cb + bj * 128) = w; } }
        }
    }
};
template <int PASS> struct EpiProj {
    static constexpr bool PERM = true, AFTER_DRAIN = false;
    unsigned char* ws;
    __device__ __forceinline__ void operator()(const f32x4 (&acc)[2][2][4][2], const Unit& u, int wr, int wc, int fr, int fq) const {
        const int row0 = u.pm * 256 + wr * 64 + fr, col0 = u.pn * 256 + wc * 32 + 8 * fq;
        const bf16_t* mg = (const bf16_t*)(ws + WS_MG) + (PASS ? 1024 : 0); float* zf = (float*)(ws + WS_UT); bf16_t* z = (bf16_t*)(ws + WS_VR);
#pragma unroll
        for (int ai = 0; ai < 2; ++ai)
#pragma unroll
            for (int m = 0; m < 4; ++m) { const int r = row0 + ai * 128 + m * 16;
#pragma unroll
                for (int bj = 0; bj < 2; ++bj) { const int c = col0 + bj * 128;
                    const u32x4 g = *(const u32x4*)(mg + (size_t)r * 2048 + c);
                    const f32x4 a0 = acc[ai][bj][m][0], a1 = acc[ai][bj][m][1];
                    f32x4 t0, t1;
                    t0[0] = a0[0] * bf_lo(g.x); t0[1] = a0[1] * bf_hi(g.x); t0[2] = a0[2] * bf_lo(g.y); t0[3] = a0[3] * bf_hi(g.y);
                    t1[0] = a1[0] * bf_lo(g.z); t1[1] = a1[1] * bf_hi(g.z); t1[2] = a1[2] * bf_lo(g.w); t1[3] = a1[3] * bf_hi(g.w);
                    float* zp = zf + (size_t)r * 1024 + c;
                    if (PASS == 0) { *(f32x4*)zp = t0; *(f32x4*)(zp + 4) = t1; }
                    else { const f32x4 p0 = *(const f32x4*)zp, p1 = *(const f32x4*)(zp + 4); t0 += p0; t1 += p1;
                        u32x4 w; w.x = cvt_pk_bf16(t0[0], t0[1]); w.y = cvt_pk_bf16(t0[2], t0[3]); w.z = cvt_pk_bf16(t1[0], t1[1]); w.w = cvt_pk_bf16(t1[2], t1[3]);
                        *(u32x4*)(z + (size_t)r * 1024 + c) = w; } } }
    }
};
struct EpiOut {
    static constexpr bool PERM = false, AFTER_DRAIN = false;
    const float* x; const float* gate; float* vpre;
    __device__ __forceinline__ void operator()(const f32x4 (&acc)[2][2][4][2], const Unit& u, int wr, int wc, int fr, int fq) const {
        const int row0 = u.pm * 256 + wr * 64 + fr, col0 = u.pn * 256 + wc * 32 + 4 * fq;
        f32x4 gv[2][2];
#pragma unroll
        for (int bj = 0; bj < 2; ++bj)
#pragma unroll
            for (int n = 0; n < 2; ++n) gv[bj][n] = *(const f32x4*)(gate + col0 + bj * 128 + n * 16);
#pragma unroll
        for (int ai = 0; ai < 2; ++ai)
#pragma unroll
            for (int m = 0; m < 4; ++m) { const size_t off = (size_t)(row0 + ai * 128 + m * 16) * 1024 + col0;
#pragma unroll
                for (int bj = 0; bj < 2; ++bj)
#pragma unroll
                    for (int n = 0; n < 2; ++n) { const f32x4 xv = *(const f32x4*)(x + off + bj * 128 + n * 16);
                        *(f32x4*)(vpre + off + bj * 128 + n * 16) = xv * ALPHA_F + gv[bj][n] * acc[ai][bj][m][n]; } }
    }
};

__device__ __forceinline__ int win_logical(int pg) {
    const int pn = pg >> 3, bj = (pg >> 2) & 1, wq = pg & 3;
    if (pn <= 1) return pn * 256 + wq * 64 + bj * 32;
    if (pn == 2) return wq < 2 ? 512 + wq * 64 + bj * 32 : 640 + bj * 64 + (wq - 2) * 32;
    if (pn >= 5 && pn <= 6) return 1280 + (pn - 5) * 256 + (wq >> 1) * 128 + bj * 64 + (wq & 1) * 32;
    if (pn >= 7 && pn <= 8) return 1792 + (pn - 7) * 256 + (wq >> 1) * 128 + bj * 64 + (wq & 1) * 32;
    return pg * 32;
}
__device__ __forceinline__ void xpose_tile(const float* src, int ldn, bf16_t* dst, int K, int p0, int k0, int lcol, float* tile) {
    const int tid = opq(threadIdx.x);
    { const int c = tid & 31, kr = tid >> 5;
#pragma unroll
      for (int ps = 0; ps < 8; ++ps) { const int k = kr + 16 * ps; tile[k * 33 + c] = src[(size_t)(k0 + k) * ldn + lcol + c]; } }
    __syncthreads();
    { const int p = tid >> 4, ks = (tid & 15) * 8; float v[8];
#pragma unroll
      for (int e = 0; e < 8; ++e) v[e] = tile[(ks + e) * 33 + p];
      u32x4 w; w.x = cvt_pk_bf16(v[0], v[1]); w.y = cvt_pk_bf16(v[2], v[3]); w.z = cvt_pk_bf16(v[4], v[5]); w.w = cvt_pk_bf16(v[6], v[7]);
      *(u32x4*)(dst + (size_t)(p0 + p) * K + k0 + ks) = w; }
    __syncthreads();
}
__device__ void phase0(const Params& P, float* tile) {
    unsigned char* ws = P.ws;
    for (int it = blockIdx.x; it < 2 * 3008; it += gridDim.x) {
        const int l = it / 3008; int t = it % 3008;
        if (t < 1600) { const int pg = t >> 3, kt = t & 7; xpose_tile(P.w_in + (size_t)l * DM * NIN, NIN, (bf16_t*)(ws + WS_WIN) + (size_t)l * NIN * DM, 1024, pg * 32, kt * 128, win_logical(pg), tile); }
        else if ((t -= 1600) < 768) { const int pg = t >> 3, kt = t & 7; xpose_tile(P.w_cond + (size_t)l * DM * 3072, 3072, (bf16_t*)(ws + WS_WC) + (size_t)l * 3072 * DM, 1024, pg * 32, kt * 128, pg * 32, tile); }
        else if ((t -= 768) < 128) { const int pg = t >> 2, kt = t & 3; xpose_tile(P.w_pa + (size_t)l * 512 * DM, 1024, (bf16_t*)(ws + WS_WPA) + (size_t)l * 1024 * 512, 512, pg * 32, kt * 128, pg * 32, tile); }
        else if ((t -= 128) < 256) { const int pg = t >> 3, kt = t & 7; xpose_tile(P.w_pr + (size_t)l * DM * DM, 1024, (bf16_t*)(ws + WS_WPR) + (size_t)l * DM * DM, 1024, pg * 32, kt * 128, pg * 32, tile); }
        else { t -= 256; const int pg = t >> 3, kt = t & 7; xpose_tile(P.w_out + (size_t)l * DM * DM, 1024, (bf16_t*)(ws + WS_WOUT) + (size_t)l * DM * DM, 1024, pg * 32, kt * 128, pg * 32, tile); }
    }
    const size_t gtid = (size_t)blockIdx.x * 512 + opq(threadIdx.x), gsz = (size_t)gridDim.x * 512;
    for (size_t e = gtid; e < (size_t)16385 * 96; e += gsz) { const int pos = (int)(e / 96), i = (int)(e % 96);
        const bool a = i < 32; const int ii = a ? i : i - 32; const float half = a ? 32.0f : 64.0f;
        const float freq = powf(10000.0f, -(float)ii / half); const float ang = (float)pos * freq;
        const float c = cosf(ang), s = sinf(ang);
        float* d = a ? (float*)(ws + WS_ROPEA) + ((size_t)pos * 32 + ii) * 2 : (float*)(ws + WS_ROPER) + ((size_t)pos * 64 + ii) * 2;
        d[0] = c; d[1] = s; }
    for (size_t e = gtid; e < (size_t)256 * 1024; e += gsz) { const int r = (int)(e >> 10), k = (int)(e & 1023);
        float v = 0.f; if (r < 128) v = P.c_sample[(size_t)r * 1024 + k]; else if (r == 128) v = P.c_prompt[k];
        v = v * sigmoidf_(v); ((bf16_t*)(ws + WS_ACOND))[e] = (bf16_t)(cvt_pk_bf16(v, 0.f) & 0xffffu); }
}

__device__ void phase_hprep(const Params& P) {
    const float* mod = (const float*)(P.ws + WS_MOD); bf16_t* H = (bf16_t*)(P.ws + WS_H);
    for (size_t e = (size_t)blockIdx.x * 512 + opq(threadIdx.x); e < (size_t)MPAD * 128; e += (size_t)gridDim.x * 512) {
        const int r = (int)(e >> 7), c = (int)(e & 127) * 8; u32x4 w = {0u, 0u, 0u, 0u};
        if (r < MREAL) { const float* x = r < LP ? P.x_prompt + (size_t)r * 1024 + c : P.x_sample + (size_t)(r - LP) * 1024 + c;
            const float* mr = mod + (size_t)(r < LP ? 128 : r - LP) * 6144;
            const f32x4 x0 = *(const f32x4*)x, x1 = *(const f32x4*)(x + 4), sh0 = *(const f32x4*)(mr + c), sh1 = *(const f32x4*)(mr + c + 4), sc0 = *(const f32x4*)(mr + 1024 + c), sc1 = *(const f32x4*)(mr + 1024 + c + 4);
            const f32x4 h0 = x0 * (sc0 + 1.0f) + sh0, h1 = x1 * (sc1 + 1.0f) + sh1;
            w.x = cvt_pk_bf16(h0[0], h0[1]); w.y = cvt_pk_bf16(h0[2], h0[3]); w.z = cvt_pk_bf16(h1[0], h1[1]); w.w = cvt_pk_bf16(h1[2], h1[3]); }
        *(u32x4*)(H + (size_t)r * 1024 + c) = w; }
}

__device__ void attn_prompt_item(const Params& P, int l, int n, int g, unsigned char* lds) {
    bf16_t* Ks = (bf16_t*)lds; bf16_t* Vt = Ks + 256 * 72;
    const bf16_t* KA = (const bf16_t*)(P.ws + WS_KA); const bf16_t* VA = (const bf16_t*)(P.ws + WS_VA); const bf16_t* GA = (const bf16_t*)(P.ws + WS_GA); bf16_t* QA = (bf16_t*)(P.ws + WS_QA);
    const int tid = opq(threadIdx.x), lane = tid & 63, w = tid >> 6, fr = lane & 15, fq = lane >> 4;
    const int krow0 = (n - 1) * 128;
    for (int c = tid; c < 2048; c += 512) { const int key = c >> 3, ch = c & 7; const int row = krow0 + key; u32x4 v = {0u, 0u, 0u, 0u};
        if (row >= 0) v = *(const u32x4*)(KA + (size_t)row * 128 + g * 64 + ch * 8);
        *(u32x4*)(Ks + key * 72 + ch * 8) = v; }
    { const int key = tid & 255, c0 = (tid >> 8) * 4; const int row = krow0 + key;
#pragma unroll
      for (int i = 0; i < 4; ++i) { const int ch = c0 + i; u32x4 v = {0u, 0u, 0u, 0u};
          if (row >= 0) v = *(const u32x4*)(VA + (size_t)row * 128 + g * 64 + ch * 8);
#pragma unroll
          for (int e = 0; e < 4; ++e) { Vt[(ch * 8 + 2 * e) * 264 + key] = (bf16_t)(v[e] & 0xffffu); Vt[(ch * 8 + 2 * e + 1) * 264 + key] = (bf16_t)(v[e] >> 16); } } }
    __syncthreads();
    const int hq = g * 4 + (w >> 1), qi0 = (w & 1) * 64;
    const float sink = P.sinks[l * 8 + hq];
    for (int qb = 0; qb < 4; ++qb) {
        const int qi = qi0 + qb * 16 + fr; const size_t qrow = (size_t)n * 128 + qi;
        const bf16x8 q0 = *(const bf16x8*)(QA + qrow * 512 + hq * 64 + fq * 8), q1 = *(const bf16x8*)(QA + qrow * 512 + hq * 64 + 32 + fq * 8);
        const int kbs = ((qi0 >> 4) + qb) & ~1;
        f32x4 s[10];
#pragma unroll
        for (int kk = 0; kk < 10; ++kk) { const bf16_t* kp = Ks + ((kbs + kk) * 16 + fr) * 72 + fq * 8;
            const bf16x8 k0 = *(const bf16x8*)kp, k1 = *(const bf16x8*)(kp + 32);
            s[kk] = mfma16(k0, q0, (f32x4){0.f, 0.f, 0.f, 0.f}); s[kk] = mfma16(k1, q1, s[kk]); }
        float mx = sink;
#pragma unroll
        for (int kk = 0; kk < 10; ++kk)
#pragma unroll
            for (int j = 0; j < 4; ++j) { const int key = (kbs + kk) * 16 + fq * 4 + j; const bool ok = key >= qi && key <= qi + 128 && (n > 0 || key >= 128);
                s[kk][j] = ok ? s[kk][j] : -INFINITY; mx = fmaxf(mx, s[kk][j]); }
        mx = fmaxf(mx, __shfl_xor(mx, 16)); mx = fmaxf(mx, __shfl_xor(mx, 32));
        float sum = 0.f;
#pragma unroll
        for (int kk = 0; kk < 10; ++kk)
#pragma unroll
            for (int j = 0; j < 4; ++j) { const float p = __expf(s[kk][j] - mx); s[kk][j] = p; sum += p; }
        sum += __shfl_xor(sum, 16); sum += __shfl_xor(sum, 32);
        const float inv = 1.0f / (sum + __expf(sink - mx));
        f32x4 o[4];
#pragma unroll
        for (int db = 0; db < 4; ++db) o[db] = (f32x4){0.f, 0.f, 0.f, 0.f};
#pragma unroll
        for (int ss = 0; ss < 5; ++ss) { const bf16x8 pf = pack8(s[2 * ss], s[2 * ss + 1]);
#pragma unroll
            for (int db = 0; db < 4; ++db) { const bf16_t* vp = Vt + (db * 16 + fr) * 264 + kbs * 16 + 32 * ss + fq * 4;
                const bf16x8 vf = cat44(*(const bf16x4*)vp, *(const bf16x4*)(vp + 16));
                o[db] = mfma16(vf, pf, o[db]); } }
#pragma unroll
        for (int db = 0; db < 4; ++db) { const size_t off = qrow * 512 + hq * 64 + db * 16 + fq * 4;
            const u32x2 gv = *(const u32x2*)(GA + off); u32x2 wv;
            wv.x = cvt_pk_bf16(o[db][0] * inv * bf_lo(gv.x), o[db][1] * inv * bf_hi(gv.x)); wv.y = cvt_pk_bf16(o[db][2] * inv * bf_lo(gv.y), o[db][3] * inv * bf_hi(gv.y));
            *(u32x2*)(QA + off) = wv; }
    }
    __syncthreads();
}
__device__ void attn_sample_item(const Params& P, int l, int b, int g, unsigned char* lds) {
    float* Kc = (float*)lds; float* Vc = Kc + 128 * 65; float* qs = Vc + 128 * 65; float* sc = qs + 256; float* kn = sc + 4 * 132; float* vn = kn + 64;
    const bf16_t* KA = (const bf16_t*)(P.ws + WS_KA); const bf16_t* VA = (const bf16_t*)(P.ws + WS_VA); const bf16_t* GA = (const bf16_t*)(P.ws + WS_GA); bf16_t* QA = (bf16_t*)(P.ws + WS_QA);
    const int tid = opq(threadIdx.x), lane = tid & 63, w = tid >> 6; const size_t row = (size_t)LP + b;
    const size_t cb = ((size_t)(l * 128 + b) * 128) * 128 + g * 64;
    const float* ck = P.cache_k + cb; const float* cv = P.cache_v + cb; float* nk = P.out + O_NKS + cb; float* nv = P.out + O_NVS + cb;
    for (int i = tid; i < 2048; i += 512) { const int kw = i >> 4, c4 = (i & 15) * 4;
        const f32x4 kv = *(const f32x4*)(ck + (size_t)kw * 128 + c4), vv = *(const f32x4*)(cv + (size_t)kw * 128 + c4);
#pragma unroll
        for (int e = 0; e < 4; ++e) { Kc[kw * 65 + c4 + e] = kv[e]; Vc[kw * 65 + c4 + e] = vv[e]; }
        if (kw > 0) { *(f32x4*)(nk + (size_t)(kw - 1) * 128 + c4) = kv; *(f32x4*)(nv + (size_t)(kw - 1) * 128 + c4) = vv; } }
    if (tid < 256) qs[tid] = bf1(QA[row * 512 + g * 256 + tid]);
    else if (tid < 320) kn[tid - 256] = bf1(KA[row * 128 + g * 64 + (tid - 256)]);
    else if (tid < 384) vn[tid - 320] = bf1(VA[row * 128 + g * 64 + (tid - 320)]);
    __syncthreads();
    { const int qh = tid >> 7, kw = tid & 127; float a = 0.f;
#pragma unroll 16
      for (int d = 0; d < 64; ++d) a += qs[qh * 64 + d] * Kc[kw * 65 + d];
      sc[qh * 132 + kw] = a;
      if (tid < 4) { float a2 = 0.f; for (int d = 0; d < 64; ++d) a2 += qs[tid * 64 + d] * kn[d]; sc[tid * 132 + 128] = a2; } }
    __syncthreads();
    if (w < 4) { const float sink = P.sinks[l * 8 + g * 4 + w];
        const float v0 = sc[w * 132 + lane], v1 = sc[w * 132 + 64 + lane], v2 = lane == 0 ? sc[w * 132 + 128] : -INFINITY;
        float mx = fmaxf(fmaxf(v0, v1), fmaxf(v2, sink));
#pragma unroll
        for (int o = 1; o < 64; o <<= 1) mx = fmaxf(mx, __shfl_xor(mx, o));
        const float p0 = __expf(v0 - mx), p1 = __expf(v1 - mx), p2 = __expf(v2 - mx); float sum = p0 + p1 + p2;
#pragma unroll
        for (int o = 1; o < 64; o <<= 1) sum += __shfl_xor(sum, o);
        const float inv = 1.0f / (sum + __expf(sink - mx));
        sc[w * 132 + lane] = p0 * inv; sc[w * 132 + 64 + lane] = p1 * inv; if (lane == 0) sc[w * 132 + 128] = p2 * inv; }
    __syncthreads();
    { const int qh = tid >> 7, d = (tid & 127) >> 1, hf = tid & 1; float a = 0.f;
#pragma unroll 16
      for (int kw = hf * 64; kw < hf * 64 + 64; ++kw) a += sc[qh * 132 + kw] * Vc[kw * 65 + d];
      a += __shfl_xor(a, 1);
      if (hf == 0) { a += sc[qh * 132 + 128] * vn[d]; const size_t off = row * 512 + (g * 4 + qh) * 64 + d;
          QA[off] = (bf16_t)(cvt_pk_bf16(a * bf1(GA[off]), 0.f) & 0xffffu); } }
    __syncthreads();
}
__device__ __forceinline__ void load_vt(const bf16_t* VR, int n, int h, bf16_t* Vt) {
    const int tidv = opq(threadIdx.x); const int tok = tidv & 127, c0 = (tidv >> 7) * 8; const size_t row = (size_t)n * 128 + tok;
#pragma unroll
    for (int i = 0; i < 8; ++i) { const int ch = c0 + i; const u32x4 v = *(const u32x4*)(VR + row * 1024 + h * 256 + ch * 8);
#pragma unroll
        for (int e = 0; e < 4; ++e) { Vt[(ch * 8 + 2 * e) * 136 + tok] = (bf16_t)(v[e] & 0xffffu); Vt[(ch * 8 + 2 * e + 1) * 136 + tok] = (bf16_t)(v[e] >> 16); } }
}
__device__ void ret_u_item(const Params& P, int n, int h, unsigned char* lds) {
    bf16_t* Kt = (bf16_t*)lds; bf16_t* Vt = Kt + 128 * 136;
    const bf16_t* KR = (const bf16_t*)(P.ws + WS_KR); const bf16_t* VR = (const bf16_t*)(P.ws + WS_VR); float* UT = (float*)(P.ws + WS_UT);
    const int tid = opq(threadIdx.x), lane = tid & 63, w = tid >> 6, fr = lane & 15, fq = lane >> 4;
    const float l2g = log2gamma(h);
    { const int tok = tid & 127, c0 = (tid >> 7) * 4; const size_t row = (size_t)n * 128 + tok; const float dec = exp2f((float)(127 - tok) * l2g);
#pragma unroll
      for (int i = 0; i < 4; ++i) { const int ch = c0 + i; const u32x4 v = *(const u32x4*)(KR + row * 512 + h * 128 + ch * 8);
#pragma unroll
          for (int e = 0; e < 4; ++e) { const unsigned pk = cvt_pk_bf16(bf_lo(v[e]) * dec, bf_hi(v[e]) * dec);
              Kt[(ch * 8 + 2 * e) * 136 + tok] = (bf16_t)(pk & 0xffffu); Kt[(ch * 8 + 2 * e + 1) * 136 + tok] = (bf16_t)(pk >> 16); } } }
    load_vt(VR, n, h, Vt);
    __syncthreads();
    f32x4 acc[2][8];
#pragma unroll
    for (int a = 0; a < 2; ++a)
#pragma unroll
        for (int b = 0; b < 8; ++b) acc[a][b] = (f32x4){0.f, 0.f, 0.f, 0.f};
#pragma unroll
    for (int ks = 0; ks < 4; ++ks) { bf16x8 vf[2];
#pragma unroll
        for (int vb = 0; vb < 2; ++vb) vf[vb] = *(const bf16x8*)(Vt + (32 * w + 16 * vb + fr) * 136 + ks * 32 + fq * 8);
#pragma unroll
        for (int kb = 0; kb < 8; ++kb) { const bf16x8 kf = *(const bf16x8*)(Kt + (16 * kb + fr) * 136 + ks * 32 + fq * 8);
#pragma unroll
            for (int vb = 0; vb < 2; ++vb) acc[vb][kb] = mfma16(kf, vf[vb], acc[vb][kb]); } }
#pragma unroll
    for (int vb = 0; vb < 2; ++vb)
#pragma unroll
        for (int kb = 0; kb < 8; ++kb) *(f32x4*)(UT + ((size_t)(n * 4 + h) * 256 + 32 * w + 16 * vb + fr) * 128 + 16 * kb + fq * 4) = acc[vb][kb];
    __syncthreads();
}
__device__ void ret_sample_item(const Params& P, int l, int b, int h, unsigned char* lds) {
    float* red = (float*)lds; float* ssum = red + 2048;
    const bf16_t* QR = (const bf16_t*)(P.ws + WS_QR); const bf16_t* KR = (const bf16_t*)(P.ws + WS_KR); const bf16_t* VR = (const bf16_t*)(P.ws + WS_VR); bf16_t* GR = (bf16_t*)(P.ws + WS_GR);
    const int tid = opq(threadIdx.x), lane = tid & 63, w = tid >> 6; const size_t row = (size_t)LP + b;
    const float gam = 1.0f - exp2f(-5.0f - (float)h);
    const u32x2 vraw = *(const u32x2*)(VR + row * 1024 + h * 256 + lane * 4);
    const f32x4 v = {bf_lo(vraw.x), bf_hi(vraw.x), bf_lo(vraw.y), bf_hi(vraw.y)};
    const size_t sb = ((size_t)(l * 128 + b) * 4 + h) * 128 * 256;
    const float* S = P.state_ret + sb; float* SN = P.out + O_NSS + sb;
    f32x4 o = {0.f, 0.f, 0.f, 0.f};
#pragma unroll 4
    for (int dk = w; dk < 128; dk += 8) { const float q = bf1(QR[row * 512 + h * 128 + dk]), k = bf1(KR[row * 512 + h * 128 + dk]);
        const f32x4 s = *(const f32x4*)(S + (size_t)dk * 256 + lane * 4); const f32x4 sn = s * gam + v * k;
        *(f32x4*)(SN + (size_t)dk * 256 + lane * 4) = sn; o += sn * q; }
    *(f32x4*)(red + w * 256 + lane * 4) = o;
    __syncthreads();
    float tot = 0.f;
    if (tid < 256) {
#pragma unroll
        for (int i = 0; i < 8; ++i) tot += red[i * 256 + tid];
        float sq = tot * tot;
#pragma unroll
        for (int of = 1; of < 64; of <<= 1) sq += __shfl_xor(sq, of);
        if (lane == 0) ssum[w] = sq; }
    __syncthreads();
    if (tid < 256) { const float total = ssum[0] + ssum[1] + ssum[2] + ssum[3]; const float rinv = rsqrtf(total * (1.0f / 256.0f) + 1e-6f);
        const size_t off = row * 1024 + h * 256 + tid; GR[off] = (bf16_t)(cvt_pk_bf16(tot * rinv * bf1(GR[off]), 0.f) & 0xffffu); }
    __syncthreads();
}
__device__ void ret_o_item(const Params& P, int n, int h, unsigned char* lds) {
    bf16_t* Ks = (bf16_t*)lds; bf16_t* Vt = Ks + 128 * 136; float* red = (float*)(Vt + 256 * 136);
    const bf16_t* QR = (const bf16_t*)(P.ws + WS_QR); const bf16_t* KR = (const bf16_t*)(P.ws + WS_KR); const bf16_t* VR = (const bf16_t*)(P.ws + WS_VR); bf16_t* GR = (bf16_t*)(P.ws + WS_GR);
    const bf16_t* ST = (const bf16_t*)(P.ws + WS_ST);
    const int tid = opq(threadIdx.x), lane = tid & 63, w = tid >> 6, fr = lane & 15, fq = lane >> 4;
    const float l2g = log2gamma(h);
    { const int r = tid >> 2, c0 = (tid & 3) * 4;
#pragma unroll
      for (int i = 0; i < 4; ++i) *(u32x4*)(Ks + r * 136 + (c0 + i) * 8) = *(const u32x4*)(KR + ((size_t)n * 128 + r) * 512 + h * 128 + (c0 + i) * 8); }
    load_vt(VR, n, h, Vt);
    __syncthreads();
    const int tg = w >> 1, dh = w & 1;
    bf16x8 qf[2][4];
#pragma unroll
    for (int qb = 0; qb < 2; ++qb)
#pragma unroll
        for (int ks = 0; ks < 4; ++ks) qf[qb][ks] = *(const bf16x8*)(QR + ((size_t)n * 128 + 32 * tg + 16 * qb + fr) * 512 + h * 128 + ks * 32 + fq * 8);
    f32x4 acc[8][2];
#pragma unroll
    for (int a = 0; a < 8; ++a)
#pragma unroll
        for (int b = 0; b < 2; ++b) acc[a][b] = (f32x4){0.f, 0.f, 0.f, 0.f};
    { const bf16_t* Sb = ST + ((size_t)(n * 4 + h) * 256 + 128 * dh) * 128;
#pragma unroll
      for (int ks = 0; ks < 4; ++ks)
#pragma unroll
          for (int dvb = 0; dvb < 8; ++dvb) { const bf16x8 sf = *(const bf16x8*)(Sb + (size_t)(16 * dvb + fr) * 128 + ks * 32 + fq * 8);
#pragma unroll
              for (int qb = 0; qb < 2; ++qb) acc[dvb][qb] = mfma16(sf, qf[qb][ks], acc[dvb][qb]); } }
#pragma unroll
    for (int s = 0; s < 4; ++s) if (s <= tg) {
        f32x4 in[2][2];
#pragma unroll
        for (int k2 = 0; k2 < 2; ++k2) { in[k2][0] = (f32x4){0.f, 0.f, 0.f, 0.f}; in[k2][1] = (f32x4){0.f, 0.f, 0.f, 0.f};
#pragma unroll
            for (int ks = 0; ks < 4; ++ks) { const bf16x8 kf = *(const bf16x8*)(Ks + (16 * (2 * s + k2) + fr) * 136 + ks * 32 + fq * 8);
#pragma unroll
                for (int qb = 0; qb < 2; ++qb) in[k2][qb] = mfma16(kf, qf[qb][ks], in[k2][qb]); } }
#pragma unroll
        for (int k2 = 0; k2 < 2; ++k2)
#pragma unroll
            for (int j = 0; j < 4; ++j) { const int key = 16 * (2 * s + k2) + fq * 4 + j; const float f = exp2f(-(float)(key + 1) * l2g);
#pragma unroll
                for (int qb = 0; qb < 2; ++qb) { const int i = 32 * tg + 16 * qb + fr; in[k2][qb][j] = key <= i ? in[k2][qb][j] * f : 0.f; } }
        bf16x8 pf[2];
#pragma unroll
        for (int qb = 0; qb < 2; ++qb) pf[qb] = pack8(in[0][qb], in[1][qb]);
#pragma unroll
        for (int dvb = 0; dvb < 8; ++dvb) { const bf16_t* vp = Vt + (128 * dh + 16 * dvb + fr) * 136 + 32 * s + fq * 4;
            const bf16x8 vf = cat44(*(const bf16x4*)vp, *(const bf16x4*)(vp + 16));
#pragma unroll
            for (int qb = 0; qb < 2; ++qb) acc[dvb][qb] = mfma16(vf, pf[qb], acc[dvb][qb]); }
    }
#pragma unroll
    for (int qb = 0; qb < 2; ++qb) { const int i = 32 * tg + 16 * qb + fr; const float scl = exp2f((float)(i + 1) * l2g); float ss = 0.f;
#pragma unroll
        for (int dvb = 0; dvb < 8; ++dvb) { acc[dvb][qb] *= scl;
#pragma unroll
            for (int j = 0; j < 4; ++j) ss += acc[dvb][qb][j] * acc[dvb][qb][j]; }
        ss += __shfl_xor(ss, 16); ss += __shfl_xor(ss, 32);
        if (fq == 0) red[dh * 128 + i] = ss; }
    __syncthreads();
#pragma unroll
    for (int qb = 0; qb < 2; ++qb) { const int i = 32 * tg + 16 * qb + fr; const float rinv = rsqrtf((red[i] + red[128 + i]) * (1.0f / 256.0f) + 1e-6f);
#pragma unroll
        for (int dvb = 0; dvb < 8; ++dvb) { const size_t off = ((size_t)n * 128 + i) * 1024 + h * 256 + 128 * dh + 16 * dvb + fq * 4;
            const u32x2 gv = *(const u32x2*)(GR + off); const f32x4 a = acc[dvb][qb] * rinv; u32x2 wv;
            wv.x = cvt_pk_bf16(a[0] * bf_lo(gv.x), a[1] * bf_hi(gv.x)); wv.y = cvt_pk_bf16(a[2] * bf_lo(gv.y), a[3] * bf_hi(gv.y));
            *(u32x2*)(GR + off) = wv; } }
    __syncthreads();
}
__device__ void phase_scan(const Params& P, int l) {
    const float* UT = (const float*)(P.ws + WS_UT); bf16_t* ST = (bf16_t*)(P.ws + WS_ST);
    for (int e = blockIdx.x * 512 + opq(threadIdx.x); e < 131072; e += gridDim.x * 512) {
        const int h = e >> 15, dv = (e >> 7) & 255, dk = e & 127;
        const float dec = __expf(128.0f * __logf(1.0f - exp2f(-5.0f - (float)h)));
        float S = 0.f;
        for (int n0 = 0; n0 < 128; n0 += 16) { float u[16];
#pragma unroll
            for (int i = 0; i < 16; ++i) u[i] = UT[(size_t)(n0 + i) * 131072 + e];
#pragma unroll
            for (int i = 0; i < 16; ++i) { ST[(size_t)(n0 + i) * 131072 + e] = (bf16_t)(cvt_pk_bf16(S, 0.f) & 0xffffu); S = S * dec + u[i]; } }
        P.out[O_NSP + (size_t)l * 131072 + ((size_t)h * 128 + dk) * 256 + dv] = S; }
}
__device__ __forceinline__ f32x4 small_acc(const bf16_t* ap, const bf16_t* bp, int K) {
    f32x4 acc = {0.f, 0.f, 0.f, 0.f};
#pragma unroll 8
    for (int ks = 0; ks < K / 32; ++ks) acc = mfma16(*(const bf16x8*)(bp + ks * 32), *(const bf16x8*)(ap + ks * 32), acc);
    return acc;
}
__device__ void proj_sample(const Params& P, int l) {
    if (blockIdx.x >= 64) return;
    const int tidv = opq(threadIdx.x); const int lane = tidv & 63, w = tidv >> 6, fr = lane & 15, fq = lane >> 4;
    const size_t row = (size_t)LP + 16 * w + fr; const int colb = 16 * blockIdx.x + fr, c0 = 16 * blockIdx.x + 4 * fq;
    const f32x4 za = small_acc((const bf16_t*)(P.ws + WS_QA) + row * 512 + fq * 8, (const bf16_t*)(P.ws + WS_WPA) + (size_t)l * 1024 * 512 + (size_t)colb * 512 + fq * 8, 512);
    const f32x4 zr = small_acc((const bf16_t*)(P.ws + WS_GR) + row * 1024 + fq * 8, (const bf16_t*)(P.ws + WS_WPR) + (size_t)l * 1024 * 1024 + (size_t)colb * 1024 + fq * 8, 1024);
    const bf16_t* mg = (const bf16_t*)(P.ws + WS_MG) + row * 2048 + c0; const u32x2 ga = *(const u32x2*)mg, gr = *(const u32x2*)(mg + 1024);
    u32x2 wv; wv.x = cvt_pk_bf16(za[0] * bf_lo(ga.x) + zr[0] * bf_lo(gr.x), za[1] * bf_hi(ga.x) + zr[1] * bf_hi(gr.x));
    wv.y = cvt_pk_bf16(za[2] * bf_lo(ga.y) + zr[2] * bf_lo(gr.y), za[3] * bf_hi(ga.y) + zr[3] * bf_hi(gr.y));
    *(u32x2*)((bf16_t*)(P.ws + WS_VR) + row * 1024 + c0) = wv;
}
__device__ void out_sample(const Params& P, int l, const float* xs) {
    if (blockIdx.x >= 64) return;
    const int tidv = opq(threadIdx.x); const int lane = tidv & 63, w = tidv >> 6, fr = lane & 15, fq = lane >> 4;
    const int b = 16 * w + fr; const size_t row = (size_t)LP + b; const int colb = 16 * blockIdx.x + fr, c0 = 16 * blockIdx.x + 4 * fq;
    const f32x4 a = small_acc((const bf16_t*)(P.ws + WS_VR) + row * 1024 + fq * 8, (const bf16_t*)(P.ws + WS_WOUT) + (size_t)l * 1024 * 1024 + (size_t)colb * 1024 + fq * 8, 1024);
    const f32x4 gate = *(const f32x4*)((const float*)(P.ws + WS_MOD) + (size_t)b * 6144 + l * 3072 + 2048 + c0);
    const f32x4 xv = *(const f32x4*)(xs + (size_t)b * 1024 + c0);
    *(f32x4*)((float*)(P.ws + WS_MG) + row * 1024 + c0) = xv * ALPHA_F + gate * a;
}
__device__ void phase_ln(const Params& P, int l) {
    const float* vpre = (const float*)(P.ws + WS_MG); const float* g = P.ln_g + l * 1024; const float* bb = P.ln_b + l * 1024;
    const float* mod = (const float*)(P.ws + WS_MOD); bf16_t* H = (bf16_t*)(P.ws + WS_H); float* X1 = (float*)(P.ws + WS_X1);
    const int tidv = opq(threadIdx.x); const int lane = tidv & 63, w = tidv >> 6;
    for (int r = blockIdx.x * 8 + w; r < MREAL; r += gridDim.x * 8) {
        const float* v = vpre + (size_t)r * 1024; f32x4 a[4]; float s = 0.f;
#pragma unroll
        for (int i = 0; i < 4; ++i) { a[i] = *(const f32x4*)(v + i * 256 + lane * 4); s += a[i][0] + a[i][1] + a[i][2] + a[i][3]; }
#pragma unroll
        for (int of = 1; of < 64; of <<= 1) s += __shfl_xor(s, of);
        const float mu = s * (1.0f / 1024.0f); float q = 0.f;
#pragma unroll
        for (int i = 0; i < 4; ++i) { a[i] -= mu; q += a[i][0] * a[i][0] + a[i][1] * a[i][1] + a[i][2] * a[i][2] + a[i][3] * a[i][3]; }
#pragma unroll
        for (int of = 1; of < 64; of <<= 1) q += __shfl_xor(q, of);
        const float rstd = rsqrtf(q * (1.0f / 1024.0f) + 1e-5f);
        float* dst = l == 0 ? X1 + (size_t)r * 1024 : (r < LP ? P.out + O_YP + (size_t)r * 1024 : P.out + O_YS + (size_t)(r - LP) * 1024);
        const float* mr = mod + (size_t)(r < LP ? 128 : r - LP) * 6144 + 3072;
#pragma unroll
        for (int i = 0; i < 4; ++i) { const int c = i * 256 + lane * 4; const f32x4 y = a[i] * rstd * *(const f32x4*)(g + c) + *(const f32x4*)(bb + c);
            *(f32x4*)(dst + c) = y;
            if (l == 0) { const f32x4 hh = y * (*(const f32x4*)(mr + 1024 + c) + 1.0f) + *(const f32x4*)(mr + c); u32x2 wv; wv.x = cvt_pk_bf16(hh[0], hh[1]); wv.y = cvt_pk_bf16(hh[2], hh[3]);
                *(u32x2*)(H + (size_t)r * 1024 + c) = wv; } }
    }
}

#ifndef PH_MASK
#define PH_MASK 0xFFFF
#endif
__global__ void __launch_bounds__(512, 2) fwd_megakernel(Params P) {
    extern __shared__ __attribute__((aligned(16))) unsigned char shm[];
    cg::grid_group grid = cg::this_grid();
    PG8_LAS unsigned char* lds3 = (PG8_LAS unsigned char*)shm;
    unsigned char* ws = P.ws;
    const int G = (int)gridDim.x, bid = (int)blockIdx.x;
    if (PH_MASK & 1) phase0(P, (float*)shm);
    grid.sync();
    if (PH_MASK & 2) {
        StaticOrder S; S.init(256, 6144, G, bid);
        pg8::EpiF32 E{(float*)(ws + WS_MOD), 6144, P.b_cond};
        pg8::gemm_phase<pg8::EpiF32, StaticOrder, false>(lds3, Gemm{(const bf16_t*)(ws + WS_ACOND), (const bf16_t*)(ws + WS_WC), 256, 6144, 1024}, S, E, nullptr);
    }
    grid.sync();
    if (PH_MASK & 4) phase_hprep(P);
    grid.sync();
#pragma unroll 1
    for (int l = 0; l < NLAYER; ++l) {
        if (PH_MASK & 8) {
            StaticOrder S; S.init(MPAD, NIN, G, bid);
            EpiIn E{l, ws, P.out};
            pg8::gemm_phase<EpiIn, StaticOrder, false>(lds3, Gemm{(const bf16_t*)(ws + WS_H), (const bf16_t*)(ws + WS_WIN) + (size_t)l * NIN * DM, MPAD, NIN, 1024}, S, E, nullptr);
        }
        grid.sync();
#pragma unroll 1
        for (int it = bid; it < 1536; it += G) {
            if (it < 256) { if (PH_MASK & 16) attn_prompt_item(P, l, it >> 1, it & 1, shm); }
            else if (it < 512) { if (PH_MASK & 32) attn_sample_item(P, l, (it - 256) >> 1, it & 1, shm); }
            else if (it < 1024) { if (PH_MASK & 64) ret_u_item(P, (it - 512) >> 2, it & 3, shm); }
            else { if (PH_MASK & 128) ret_sample_item(P, l, (it - 1024) >> 2, it & 3, shm); }
        }
        grid.sync();
        if (PH_MASK & 256) phase_scan(P, l);
        grid.sync();
        if (PH_MASK & 512)
#pragma unroll 1
        for (int it = bid; it < 512; it += G) ret_o_item(P, it >> 2, it & 3, shm);
        grid.sync();
        if (PH_MASK & 1024) {
            proj_sample(P, l);
            StaticOrder S; S.init(LP, 1024, G, bid);
            EpiProj<0> EA{ws}; EpiProj<1> EB{ws};
            pg8::gemm_phase<EpiProj<0>, StaticOrder, false>(lds3, Gemm{(const bf16_t*)(ws + WS_QA), (const bf16_t*)(ws + WS_WPA) + (size_t)l * 1024 * 512, LP, 1024, 512}, S, EA, nullptr);
            pg8::gemm_phase<EpiProj<1>, StaticOrder, false>(lds3, Gemm{(const bf16_t*)(ws + WS_GR), (const bf16_t*)(ws + WS_WPR) + (size_t)l * 1024 * 1024, LP, 1024, 1024}, S, EB, nullptr);
        }
        grid.sync();
        if (PH_MASK & 2048) {
            const float* xp = l == 0 ? P.x_prompt : (const float*)(ws + WS_X1);
            const float* xs = l == 0 ? P.x_sample : (const float*)(ws + WS_X1) + (size_t)LP * 1024;
            out_sample(P, l, xs);
            StaticOrder S; S.init(LP, 1024, G, bid);
            EpiOut E{xp, (const float*)(ws + WS_MOD) + (size_t)128 * 6144 + l * 3072 + 2048, (float*)(ws + WS_MG)};
            pg8::gemm_phase<EpiOut, StaticOrder, false>(lds3, Gemm{(const bf16_t*)(ws + WS_VR), (const bf16_t*)(ws + WS_WOUT) + (size_t)l * 1024 * 1024, LP, 1024, 1024}, S, E, nullptr);
        }
        grid.sync();
        if (PH_MASK & 4096) phase_ln(P, l);
        if (l + 1 < NLAYER) grid.sync();
    }
}

extern "C" void kernel_launch(void* const* d_in, const int* in_sizes, int n_in, void* d_out, int out_size, void* d_ws, size_t ws_size, hipStream_t stream) {
    static int grid = 0;
    if (grid == 0) {
        if (n_in != 16 || (size_t)out_size != O_END || ws_size < WS_END) { fprintf(stderr, "kernel_launch: unexpected shapes (n_in %d out %d ws %zu need %zu)\n", n_in, out_size, ws_size, (size_t)WS_END); grid = -1; return; }
        int dev = 0, cus = 0, per_cu = 0;
        hipGetDevice(&dev); hipDeviceGetAttribute(&cus, hipDeviceAttributeMultiprocessorCount, dev);
        if (hipFuncSetAttribute((const void*)fwd_megakernel, hipFuncAttributeMaxDynamicSharedMemorySize, LDS_BYTES) != hipSuccess) { fprintf(stderr, "kernel_launch: hipFuncSetAttribute failed\n"); grid = -1; return; }
        if (hipOccupancyMaxActiveBlocksPerMultiprocessor(&per_cu, (const void*)fwd_megakernel, 512, LDS_BYTES) != hipSuccess || per_cu < 1) { fprintf(stderr, "kernel_launch: occupancy query says %d\n", per_cu); per_cu = 1; }
        (void)hipGetLastError();
        grid = cus;
    }
    if (grid < 0) return;
    Params p{};
    p.x_prompt = (const float*)d_in[0]; p.x_sample = (const float*)d_in[1]; p.c_prompt = (const float*)d_in[2]; p.c_sample = (const float*)d_in[3];
    p.cache_k = (const float*)d_in[4]; p.cache_v = (const float*)d_in[5]; p.state_ret = (const float*)d_in[6]; p.w_in = (const float*)d_in[7];
    p.sinks = (const float*)d_in[8]; p.w_cond = (const float*)d_in[9]; p.b_cond = (const float*)d_in[10]; p.w_pa = (const float*)d_in[11];
    p.w_pr = (const float*)d_in[12]; p.w_out = (const float*)d_in[13]; p.ln_g = (const float*)d_in[14]; p.ln_b = (const float*)d_in[15];
    p.out = (float*)d_out; p.ws = (unsigned char*)d_ws;
    void* args[] = {&p};
    const hipError_t e = hipLaunchCooperativeKernel((const void*)fwd_megakernel, dim3(grid), dim3(512), args, LDS_BYTES, stream);
    if (e != hipSuccess) fprintf(stderr, "kernel_launch: cooperative launch failed: %s (grid %d)\n", hipGetErrorString(e), grid);
}
```

```cpp
#include <hip/hip_runtime.h>
#include <hip/hip_cooperative_groups.h>
#include <cstdio>
namespace cg = cooperative_groups;
namespace pg8 {
#define PG8_LAS __attribute__((address_space(3)))
typedef unsigned short bf16_t;
typedef short bf16x8 __attribute__((ext_vector_type(8)));
typedef float f32x4 __attribute__((ext_vector_type(4)));
typedef unsigned u32x4 __attribute__((ext_vector_type(4)));
constexpr int BM = 256, BK = 64, HALF = 128, HTB = HALF * BK * 2  , STAGE_BYTES = 8 * HTB, NXCD = 8, WGM = 8;

__host__ __device__ __forceinline__ int lds_byte(int r, int c) { const int st = (r >> 4) * 2 + (c >> 5), rr = r & 15, cc = c & 31, ob = rr * 64 + cc * 2; return st * 1024 + (ob ^ (((ob >> 9) & 1) << 5)); }
__host__ __device__ __forceinline__ void stage_rc(int b, int& R, int& C) { const int st = b / 1024, sb = b % 1024, swz = sb ^ (((sb >> 9) & 1) << 5); R = (st >> 1) * 16 + swz / 64; C = (st & 1) * 32 + (swz % 64) / 2; }
__host__ __device__ __forceinline__ int perm32(int rho) { const int n = rho >> 4, i = rho & 15; return 8 * (i >> 2) + 4 * n + (i & 3); }

struct Unit { int pm, pn; };
struct Gemm { const bf16_t* A; const bf16_t* Bt; int M, N, K; };

struct StaticOrder {
    int nM, nN, nwg, G, c;
    __host__ __device__ void init(int M, int N, int G_, int c_) { nM = M / BM; nN = N / BM; nwg = nM * nN; G = G_; c = c_; }
    __host__ __device__ bool next(int i, Unit& u) const {
        const long L = (long)i * G + c; if (L >= nwg) return false;
        int wgid = (int)L; { const int q = nwg / NXCD, r = nwg % NXCD, xcd = wgid % NXCD, off = wgid / NXCD; wgid = (xcd < r ? xcd * (q + 1) : r * (q + 1) + (xcd - r) * q) + off; }
        const int nig = WGM * nN, gid = wgid / nig, fm = gid * WGM, gsz = (nM - fm) < WGM ? (nM - fm) : WGM;
        u.pm = fm + ((wgid % nig) % gsz); u.pn = (wgid % nig) / gsz; return true;
    }
    __device__ __forceinline__ void a_ready(const Unit&) const {}
    __device__ __forceinline__ void done(const Unit&) const {}
};
__device__ __forceinline__ unsigned cvt_pk_bf16(float lo, float hi) { unsigned r; asm volatile("v_cvt_pk_bf16_f32 %0, %1, %2" : "=v"(r) : "v"(lo), "v"(hi)); return r; }
struct EpiF32 {
    static constexpr bool PERM = false, AFTER_DRAIN = false;
    float* C; int ldc; const float* bias;
    __device__ __forceinline__ void operator()(const f32x4 (&acc)[2][2][4][2], const Unit& u, int wr, int wc, int fr, int fq) const {
        const int row0 = u.pm * BM + wr * 64 + fr, col0 = u.pn * BM + wc * 32 + 4 * fq;
        f32x4 bv[2][2];
#pragma unroll
        for (int bj = 0; bj < 2; ++bj)
#pragma unroll
            for (int n = 0; n < 2; ++n) bv[bj][n] = bias ? *(const f32x4*)(bias + col0 + bj * HALF + n * 16) : (f32x4){0.f, 0.f, 0.f, 0.f};
#pragma unroll
        for (int ai = 0; ai < 2; ++ai)
#pragma unroll
            for (int m = 0; m < 4; ++m) { float* rowp = C + (size_t)(row0 + ai * HALF + m * 16) * ldc + col0;
#pragma unroll
                for (int bj = 0; bj < 2; ++bj)
#pragma unroll
                    for (int n = 0; n < 2; ++n) *(f32x4*)(rowp + bj * HALF + n * 16) = acc[ai][bj][m][n] + bv[bj][n]; }
    }
};
template <class Epi, class Sched, bool STAMP = false>
__device__ __forceinline__ void gemm_phase(PG8_LAS unsigned char* lds, const Gemm g, const Sched& S, const Epi& E, unsigned long long* stamps) {
    int tid_ = threadIdx.x; asm volatile("" : "+v"(tid_)); const int tid = tid_, wid = __builtin_amdgcn_readfirstlane(tid >> 6), lane = tid & 63, wr = wid >> 2, wc = wid & 3, fr = lane & 15, fq = lane >> 4;
    const int K = g.K, nt = K / BK;
    int ts_lo = 0, ts_hi = 0, nts = 0; const unsigned long long rt_entry = STAMP ? (unsigned long long)wall_clock64() : 0ull;
#define PG8_STAMP() do { if (STAMP && wid == 0 && nts < 64) { const unsigned long long _c = (unsigned long long)clock64(); \
        ts_lo = (lane == nts) ? (int)(unsigned)_c : ts_lo; ts_hi = (lane == nts) ? (int)(unsigned)(_c >> 32) : ts_hi; ++nts; } } while (0)
    PG8_STAMP();
    unsigned voffA[2], voffB[2];
#pragma unroll
    for (int i = 0; i < 2; ++i) { int R, C; stage_rc(tid * 16 + i * 8192, R, C); const int Rb = Epi::PERM ? ((R & ~31) + perm32(R & 31)) : R;
        voffA[i] = (unsigned)(R * K + C) * 2u; voffB[i] = (unsigned)(Rb * K + C) * 2u; }
    const size_t kstep = (size_t)(BK * 2);
    const size_t hstep = (size_t)HALF * K * 2;
    const size_t tstep = 2 * hstep;
    const unsigned ldsw = (unsigned)wid * 1024u;
    const int aoff = lds_byte(wr * 64 + fr, fq * 8), boff = lds_byte(wc * 32 + fr, fq * 8);
#define PG8_SA(b, h) (((b) * 2 + (h)) * HTB)
#define PG8_SB(b, h) ((4 + (b) * 2 + (h)) * HTB)
#define PG8_STAGE(bufoff, gbase, voff) do { _Pragma("unroll") for (int _i = 0; _i < 2; ++_i) \
        __builtin_amdgcn_global_load_lds((const unsigned*)((const char*)(gbase) + (voff)[_i]), (PG8_LAS unsigned*)(lds + (bufoff) + ldsw + _i * 8192), 16, 0, 0); } while (0)
#define PG8_LDA(dst, b, h) do { _Pragma("unroll") for (int m = 0; m < 4; ++m) _Pragma("unroll") for (int k = 0; k < 2; ++k) dst[m][k] = *(const PG8_LAS bf16x8*)(lds + PG8_SA(b, h) + aoff + m * 2048 + k * 1024); } while (0)
#define PG8_LDB(dst, b, h) do { _Pragma("unroll") for (int n = 0; n < 2; ++n) _Pragma("unroll") for (int k = 0; k < 2; ++k) dst[n][k] = *(const PG8_LAS bf16x8*)(lds + PG8_SB(b, h) + boff + n * 2048 + k * 1024); } while (0)
#define PG8_MMA(ai, bj, At, Bt) do { __builtin_amdgcn_s_setprio(1); _Pragma("unroll") for (int m = 0; m < 4; ++m) _Pragma("unroll") for (int n = 0; n < 2; ++n) _Pragma("unroll") for (int k = 0; k < 2; ++k) \
        acc[ai][bj][m][n] = __builtin_amdgcn_mfma_f32_16x16x32_bf16(Bt[n][k], At[m][k], acc[ai][bj][m][n], 0, 0, 0); __builtin_amdgcn_s_setprio(0); } while (0)
#define PG8_WAIT_V(n) asm volatile("s_waitcnt vmcnt(" #n ")" ::: "memory")
#define PG8_WAIT_L(n) asm volatile("s_waitcnt lgkmcnt(" #n ")" ::: "memory")
#define PG8_BAR __builtin_amdgcn_s_barrier()
#define PG8_SCHED __builtin_amdgcn_sched_barrier(0)
    Unit cur, nxt; int ui = 0;
    if (!S.next(0, cur)) return;
    f32x4 acc[2][2][4][2];
#pragma unroll
    for (int a = 0; a < 2; ++a)
#pragma unroll
        for (int b = 0; b < 2; ++b)
#pragma unroll
            for (int m = 0; m < 4; ++m)
#pragma unroll
                for (int n = 0; n < 2; ++n) acc[a][b][m][n] = (f32x4){0.f, 0.f, 0.f, 0.f};
    bf16x8 At[4][2], B0[2][2], B1[2][2];
    const char* cA = (const char*)g.A + (size_t)cur.pm * tstep; const char* cB = (const char*)g.Bt + (size_t)cur.pn * tstep;
    S.a_ready(cur);
    PG8_STAGE(PG8_SB(0, 0), cB, voffB); PG8_STAGE(PG8_SA(0, 0), cA, voffA); PG8_STAGE(PG8_SB(0, 1), cB + hstep, voffB); PG8_STAGE(PG8_SA(0, 1), cA + hstep, voffA);
    if (wr == 1) PG8_BAR;
    PG8_WAIT_V(4); PG8_BAR;
    PG8_STAGE(PG8_SB(1, 0), cB + kstep, voffB); PG8_STAGE(PG8_SA(1, 0), cA + kstep, voffA); PG8_STAGE(PG8_SB(1, 1), cB + hstep + kstep, voffB);
    PG8_WAIT_V(6); PG8_BAR;
    PG8_STAMP();
    for (;;) {
        const bool has_next = S.next(ui + 1, nxt);
        const char* nA = has_next ? (const char*)g.A + (size_t)nxt.pm * tstep : cA; const char* nB = has_next ? (const char*)g.Bt + (size_t)nxt.pn * tstep : cB;
        for (int t = 0; t < nt; t += 2) {
            const bool last = (t == nt - 2);
            const char* a1 = cA + (size_t)(t + 1) * kstep;
            const char* a2 = last ? nA : cA + (size_t)(t + 2) * kstep; const char* b2 = last ? nB : cB + (size_t)(t + 2) * kstep;
            const char* a3 = a2 + kstep; const char* b3 = b2 + kstep;
            if (last && has_next) S.a_ready(nxt);
            PG8_LDB(B0, 0, 0); PG8_SCHED; PG8_LDA(At, 0, 0); PG8_STAGE(PG8_SA(1, 1), a1 + hstep, voffA);
            PG8_WAIT_L(8); PG8_BAR; PG8_WAIT_L(0); PG8_MMA(0, 0, At, B0); PG8_BAR; PG8_SCHED;
            PG8_LDB(B1, 0, 1); PG8_STAGE(PG8_SB(0, 0), b2, voffB);
            PG8_BAR; PG8_WAIT_L(0); PG8_MMA(0, 1, At, B1); PG8_BAR;
            PG8_LDA(At, 0, 1); PG8_STAGE(PG8_SA(0, 0), a2, voffA);
            PG8_BAR; PG8_WAIT_L(0); PG8_MMA(1, 0, At, B0); PG8_BAR; PG8_SCHED;
            PG8_STAGE(PG8_SB(0, 1), b2 + hstep, voffB);
            PG8_WAIT_V(6); PG8_BAR; PG8_MMA(1, 1, At, B1); PG8_BAR;
            PG8_LDB(B0, 1, 0); PG8_SCHED; PG8_LDA(At, 1, 0); PG8_STAGE(PG8_SA(0, 1), a2 + hstep, voffA);
            PG8_WAIT_L(8); PG8_BAR; PG8_WAIT_L(0); PG8_MMA(0, 0, At, B0); PG8_BAR; PG8_SCHED;
            PG8_LDB(B1, 1, 1); PG8_STAGE(PG8_SB(1, 0), b3, voffB);
            PG8_BAR; PG8_WAIT_L(0); PG8_MMA(0, 1, At, B1); PG8_BAR;
            PG8_LDA(At, 1, 1); PG8_STAGE(PG8_SA(1, 0), a3, voffA);
            PG8_BAR; PG8_WAIT_L(0); PG8_MMA(1, 0, At, B0); PG8_BAR; PG8_SCHED;
            PG8_STAGE(PG8_SB(1, 1), b3 + hstep, voffB);
            PG8_WAIT_V(6); PG8_BAR; PG8_MMA(1, 1, At, B1); PG8_BAR;
        }
        PG8_STAMP();
        if constexpr (!Epi::AFTER_DRAIN) { E(acc, cur, wr, wc, fr, fq); S.done(cur); }
        PG8_STAMP();
        if (!has_next) break;
#pragma unroll
        for (int a = 0; a < 2; ++a)
#pragma unroll
            for (int b = 0; b < 2; ++b)
#pragma unroll
                for (int m = 0; m < 4; ++m)
#pragma unroll
                    for (int n = 0; n < 2; ++n) acc[a][b][m][n] = (f32x4){0.f, 0.f, 0.f, 0.f};
        cur = nxt; cA = nA; cB = nB; ++ui;
    }
    PG8_WAIT_V(0);
    if (wr == 0) PG8_BAR;
    PG8_BAR;
    if constexpr (Epi::AFTER_DRAIN) { E.fused(acc, cur, wr, wc, fr, fq, lds, wid, lane); S.done(cur); }
    PG8_STAMP();
    if (STAMP && wid == 0) { stamps[lane] = lane < nts ? (((unsigned long long)(unsigned)ts_hi << 32) | (unsigned)ts_lo) : 0ull;
        if (lane == 62) stamps[62] = rt_entry; if (lane == 63) stamps[63] = (unsigned long long)wall_clock64(); }
#undef PG8_STAMP
#undef PG8_SA
#undef PG8_SB
#undef PG8_STAGE
#undef PG8_LDA
#undef PG8_LDB
#undef PG8_MMA
#undef PG8_WAIT_V
#undef PG8_WAIT_L
#undef PG8_BAR
#undef PG8_SCHED
}
}
#include <cstdlib>
#include <vector>

#define XB_TMO      128
#define XB_XCNT(j)  (256  + 64 * (j))
#define XB_XSUB(j)  (1280 + 64 * (j))
#define XB_XGEN(j)  (2304 + 64 * (j))
#define XB_TOP      3328
#define XB_TOPGEN   3392
#define XCD_BAR_WORDS 3456
#define XB_SPIN_CAP (1u << 18)
#define LAS __attribute__((address_space(3)))

__device__ __forceinline__ unsigned xb_ld(unsigned* p)              { return __hip_atomic_load(p, __ATOMIC_RELAXED, __HIP_MEMORY_SCOPE_AGENT); }
__device__ __forceinline__ unsigned xb_add(unsigned* p, unsigned v) { return __hip_atomic_fetch_add(p, v, __ATOMIC_RELAXED, __HIP_MEMORY_SCOPE_AGENT); }
__device__ __forceinline__ unsigned xb_xcc_id() { return (unsigned)__builtin_amdgcn_s_getreg((3 << 11) | 20) & 0xFu; }
#define XB_SPIN(cond, bar) do { unsigned _sp = 0; while (cond) { __builtin_amdgcn_s_sleep(1); \
    if ((++_sp & 255u) == 0u) { if (xb_ld(&(bar)[XB_TMO])) break; if (_sp > XB_SPIN_CAP) { atomicAdd(&(bar)[XB_TMO], 1u); break; } } } } while (0)

struct XcdBarrier {
    unsigned* bar; unsigned x;
    volatile LAS unsigned* st;
};

__device__ __forceinline__ XcdBarrier xcd_barrier_post(unsigned* bar, volatile LAS unsigned* st) {
    XcdBarrier b; b.bar = bar; b.x = xb_xcc_id(); b.st = st;
    if (threadIdx.x == 0) (void)xb_add(&bar[XB_XCNT(b.x)], 1u);
    return b;
}
__device__ __forceinline__ void xcd_barrier_complete(unsigned* bar, unsigned x, unsigned& nloc, unsigned& nx) {
    const unsigned G = gridDim.x * gridDim.y * gridDim.z;
    unsigned sum, cnt, mine, sp = 0u;
    for (;;) {
        sum = 0u; cnt = 0u; mine = 0u;
#pragma unroll
        for (unsigned j = 0; j < 16; ++j) { const unsigned c = xb_ld(&bar[XB_XCNT(j)]); sum += c; cnt += (c > 0u) ? 1u : 0u; mine = (j == x) ? c : mine; }
        if (sum == G) break;
        __builtin_amdgcn_s_sleep(1);
        if ((++sp & 255u) == 0u) { if (xb_ld(&bar[XB_TMO])) break; if (sp > XB_SPIN_CAP) { atomicAdd(&bar[XB_TMO], 1u); break; } }
    }
    nloc = mine > 0u ? mine : 1u; nx = cnt > 0u ? cnt : 1u;
}

__device__ __forceinline__ void xcd_barrier(const XcdBarrier& b) {
    asm volatile("s_waitcnt vmcnt(0)" ::: "memory");
    __syncthreads();
    if (threadIdx.x == 0) {
        unsigned* bar = b.bar;
        __builtin_amdgcn_s_waitcnt(0);
        unsigned nloc = b.st[0], nx = b.st[1];
        if (nloc == 0u) { xcd_barrier_complete(bar, b.x, nloc, nx); b.st[0] = nloc; b.st[1] = nx; }
        const unsigned old = xb_add(&bar[XB_XSUB(b.x)], 1u);
        const unsigned gen = old / nloc;
        if (old + 1u == (gen + 1u) * nloc) {
            __builtin_amdgcn_fence(__ATOMIC_RELEASE, "agent");
            asm volatile("s_waitcnt vmcnt(0)" ::: "memory");
            const unsigned og = xb_add(&bar[XB_TOP], 1u);
            const unsigned tg = og / nx;
            if (og + 1u == (tg + 1u) * nx) xb_add(&bar[XB_TOPGEN], 1u);
            else XB_SPIN(xb_ld(&bar[XB_TOPGEN]) == tg, bar);
            __builtin_amdgcn_fence(__ATOMIC_ACQUIRE, "agent");
            xb_add(&bar[XB_XGEN(b.x)], 1u);
            asm volatile("s_waitcnt vmcnt(0)" ::: "memory");
        } else {
            XB_SPIN(xb_ld(&bar[XB_XGEN(b.x)]) == gen, bar);
            __builtin_amdgcn_fence(__ATOMIC_ACQUIRE, "agent");
            asm volatile("s_waitcnt vmcnt(0)" ::: "memory");
        }
    }
    __syncthreads();
}

using pg8::bf16_t; using pg8::bf16x8; using pg8::f32x4; using pg8::u32x4; using pg8::Unit; using pg8::Gemm; using pg8::StaticOrder; using pg8::cvt_pk_bf16;
typedef unsigned u32x2 __attribute__((ext_vector_type(2)));
typedef short bf16x4 __attribute__((ext_vector_type(4)));

constexpr int DM = 1024, LP = 16384, NSMP = 128, MREAL = LP + NSMP, MPAD = 16640, NIN = 6400, NLAYER = 2;
constexpr float ALPHA_F = 1.41421356237309515f;
constexpr int LDS_BYTES = 131072 + 256;
constexpr size_t al256(size_t x) { return (x + 255) & ~(size_t)255; }
constexpr size_t WS_WIN = 0;
constexpr size_t WS_WC = WS_WIN + al256((size_t)NLAYER * NIN * DM * 2);
constexpr size_t WS_WPA = WS_WC + al256((size_t)NLAYER * 3072 * DM * 2);
constexpr size_t WS_WPR = WS_WPA + al256((size_t)NLAYER * 1024 * 512 * 2);
constexpr size_t WS_WOUT = WS_WPR + al256((size_t)NLAYER * 1024 * 1024 * 2);
constexpr size_t WS_ACOND = WS_WOUT + al256((size_t)NLAYER * 1024 * 1024 * 2);
constexpr size_t WS_MOD = WS_ACOND + al256((size_t)256 * 1024 * 2);
constexpr size_t WS_ROPEA = WS_MOD + al256((size_t)256 * 6144 * 4);
constexpr size_t WS_ROPER = WS_ROPEA + al256((size_t)16385 * 32 * 8);
constexpr size_t WS_H = WS_ROPER + al256((size_t)16385 * 64 * 8);
constexpr size_t WS_X1 = WS_H + al256((size_t)MPAD * 1024 * 2);
constexpr size_t WS_QA = WS_X1 + al256((size_t)MREAL * 1024 * 4);
constexpr size_t WS_KA = WS_QA + al256((size_t)MPAD * 512 * 2);
constexpr size_t WS_VA = WS_KA + al256((size_t)MPAD * 128 * 2);
constexpr size_t WS_GA = WS_VA + al256((size_t)MPAD * 128 * 2);
constexpr size_t WS_QR = WS_GA + al256((size_t)MPAD * 512 * 2);
constexpr size_t WS_KR = WS_QR + al256((size_t)MPAD * 512 * 2);
constexpr size_t WS_VR = WS_KR + al256((size_t)MPAD * 512 * 2);
constexpr size_t WS_GR = WS_VR + al256((size_t)MPAD * 1024 * 2);
constexpr size_t WS_MG = WS_GR + al256((size_t)MPAD * 1024 * 2);
constexpr size_t WS_UT = WS_MG + al256((size_t)MPAD * 2048 * 2);
constexpr size_t WS_ST = WS_UT + al256((size_t)128 * 4 * 256 * 128 * 4);
constexpr size_t WS_BAR = WS_ST + al256((size_t)128 * 4 * 256 * 128 * 2);
constexpr size_t WS_END = WS_BAR + al256((size_t)XCD_BAR_WORDS * 4);
constexpr size_t O_YP = 0, O_YS = O_YP + (size_t)LP * DM, O_NKP = O_YS + (size_t)NSMP * DM, O_NVP = O_NKP + 32768, O_NSP = O_NVP + 32768,
                 O_NKS = O_NSP + 262144, O_NVS = O_NKS + 4194304, O_NSS = O_NVS + 4194304, O_END = O_NSS + 33554432;

struct Params {
    const float *x_prompt, *x_sample, *c_prompt, *c_sample, *cache_k, *cache_v, *state_ret, *w_in, *sinks, *w_cond, *b_cond, *w_pa, *w_pr, *w_out, *ln_g, *ln_b;
    float* out; unsigned char* ws;
};

__device__ __forceinline__ int opq(int x) { asm volatile("" : "+v"(x)); return x; }
__device__ __forceinline__ float bf_lo(unsigned u) { return __uint_as_float(u << 16); }
__device__ __forceinline__ float bf_hi(unsigned u) { return __uint_as_float(u & 0xffff0000u); }
__device__ __forceinline__ float bf1(bf16_t b) { return __uint_as_float(((unsigned)b) << 16); }
__device__ __forceinline__ f32x4 mfma16(bf16x8 a, bf16x8 b, f32x4 c) { return __builtin_amdgcn_mfma_f32_16x16x32_bf16(a, b, c, 0, 0, 0); }
__device__ __forceinline__ float sigmoidf_(float x) { return __builtin_amdgcn_rcpf(1.0f + __expf(-x)); }
__device__ __forceinline__ float log2gamma(int h) { return __log2f(1.0f - exp2f(-5.0f - (float)h)); }
__device__ __forceinline__ bf16x8 pack8(f32x4 a, f32x4 b) {
    u32x4 r; r.x = cvt_pk_bf16(a[0], a[1]); r.y = cvt_pk_bf16(a[2], a[3]); r.z = cvt_pk_bf16(b[0], b[1]); r.w = cvt_pk_bf16(b[2], b[3]);
    return __builtin_bit_cast(bf16x8, r);
}
__device__ __forceinline__ bf16x8 cat44(bf16x4 a, bf16x4 b) { return __builtin_shufflevector(a, b, 0, 1, 2, 3, 4, 5, 6, 7); }

struct EpiIn {
    static constexpr bool PERM = true, AFTER_DRAIN = false;
    int layer; unsigned char* ws; float* out;
    __device__ __forceinline__ void operator()(const f32x4 (&acc)[2][2][4][2], const Unit& u, int wr, int wc, int fr, int fq) const {
        const int pn = u.pn; const int row0 = u.pm * 256 + wr * 64 + fr;
        const bool ropeA = (pn <= 1) || (pn == 2 && wc < 2), ropeR = (pn >= 5 && pn <= 8);
        if (ropeA || ropeR) {
            bf16_t* dst; int ld, c1, part; float sc; const float* tab; int tld;
            if (ropeA) { tab = (const float*)(ws + WS_ROPEA) + 2 * (8 * fq); tld = 64; part = 32;
                if (pn <= 1) { dst = (bf16_t*)(ws + WS_QA); ld = 512; c1 = pn * 256 + wc * 64 + 8 * fq; sc = 0.125f; }
                else { dst = (bf16_t*)(ws + WS_KA); ld = 128; c1 = wc * 64 + 8 * fq; sc = 1.0f; } }
            else { tab = (const float*)(ws + WS_ROPER) + 2 * (32 * (wc & 1) + 8 * fq); tld = 128; part = 64;
                if (pn <= 6) { dst = (bf16_t*)(ws + WS_QR); ld = 512; c1 = (pn - 5) * 256 + (wc >> 1) * 128 + (wc & 1) * 32 + 8 * fq; sc = 1.0f; }
                else { dst = (bf16_t*)(ws + WS_KR); ld = 512; c1 = (pn - 7) * 256 + (wc >> 1) * 128 + (wc & 1) * 32 + 8 * fq; sc = 0.08838834764831845f; } }
            const bool isk = (pn == 2);
#pragma unroll
            for (int ai = 0; ai < 2; ++ai)
#pragma unroll
                for (int m = 0; m < 4; ++m) {
                    const int r = row0 + ai * 128 + m * 16; const int pos = r < LP ? r : LP;
                    const f32x4* tp = (const f32x4*)(tab + (size_t)pos * tld);
                    f32x4 o1[2], o2[2];
#pragma unroll
                    for (int n = 0; n < 2; ++n) { const f32x4 t0 = tp[2 * n], t1 = tp[2 * n + 1];
                        const f32x4 x1 = acc[ai][0][m][n], x2 = acc[ai][1][m][n];
                        const float cs[4] = {t0[0], t0[2], t1[0], t1[2]}, sn[4] = {t0[1], t0[3], t1[1], t1[3]};
#pragma unroll
                        for (int e = 0; e < 4; ++e) { o1[n][e] = (x1[e] * cs[e] - x2[e] * sn[e]) * sc; o2[n][e] = (x2[e] * cs[e] + x1[e] * sn[e]) * sc; } }
                    u32x4 w1, w2; w1.x = cvt_pk_bf16(o1[0][0], o1[0][1]); w1.y = cvt_pk_bf16(o1[0][2], o1[0][3]); w1.z = cvt_pk_bf16(o1[1][0], o1[1][1]); w1.w = cvt_pk_bf16(o1[1][2], o1[1][3]);
                    w2.x = cvt_pk_bf16(o2[0][0], o2[0][1]); w2.y = cvt_pk_bf16(o2[0][2], o2[0][3]); w2.z = cvt_pk_bf16(o2[1][0], o2[1][1]); w2.w = cvt_pk_bf16(o2[1][2], o2[1][3]);
                    *(u32x4*)(dst + (size_t)r * ld + c1) = w1; *(u32x4*)(dst + (size_t)r * ld + c1 + part) = w2;
                    if (isk && r >= LP - 128 && r < MREAL) {
                        float* fo = (r < LP) ? out + O_NKP + (size_t)layer * 16384 + (size_t)(r - (LP - 128)) * 128 + c1
                                             : out + O_NKS + ((size_t)(layer * 128 + (r - LP)) * 128 + 127) * 128 + c1;
                        *(f32x4*)(fo) = o1[0]; *(f32x4*)(fo + 4) = o1[1]; *(f32x4*)(fo + 32) = o2[0]; *(f32x4*)(fo + 36) = o2[1];
                    }
                }
        } else if (pn == 2) {
            bf16_t* dst = (bf16_t*)(ws + WS_VA);
#pragma unroll
            for (int ai = 0; ai < 2; ++ai)
#pragma unroll
                for (int m = 0; m < 4; ++m) { const int r = row0 + ai * 128 + m * 16;
#pragma unroll
                    for (int bj = 0; bj < 2; ++bj) { const int c = bj * 64 + 32 * (wc - 2) + 8 * fq; const f32x4 a0 = acc[ai][bj][m][0], a1 = acc[ai][bj][m][1];
                        u32x4 w; w.x = cvt_pk_bf16(a0[0], a0[1]); w.y = cvt_pk_bf16(a0[2], a0[3]); w.z = cvt_pk_bf16(a1[0], a1[1]); w.w = cvt_pk_bf16(a1[2], a1[3]);
                        *(u32x4*)(dst + (size_t)r * 128 + c) = w;
                        if (r >= LP - 128 && r < MREAL) {
                            float* fo = (r < LP) ? out + O_NVP + (size_t)layer * 16384 + (size_t)(r - (LP - 128)) * 128 + c
                                                 : out + O_NVS + ((size_t)(layer * 128 + (r - LP)) * 128 + 127) * 128 + c;
                            *(f32x4*)(fo) = a0; *(f32x4*)(fo + 4) = a1; } } }
        } else {
            bf16_t* dst; int ld, cb, op;
            if (pn <= 4) { dst = (bf16_t*)(ws + WS_GA); ld = 512; cb = (pn - 3) * 256; op = 1; }
            else if (pn <= 12) { dst = (bf16_t*)(ws + WS_VR); ld = 1024; cb = (pn - 9) * 256; op = 0; }
            else if (pn <= 16) { dst = (bf16_t*)(ws + WS_GR); ld = 1024; cb = (pn - 13) * 256; op = 1; }
            else { dst = (bf16_t*)(ws + WS_MG); ld = 2048; cb = (pn - 17) * 256; op = 2; }
            cb += wc * 32 + 8 * fq;
#pragma unroll
            for (int ai = 0; ai < 2; ++ai)
#pragma unroll
                for (int m = 0; m < 4; ++m) { const int r = row0 + ai * 128 + m * 16;
#pragma unroll
                    for (int bj = 0; bj < 2; ++bj) { float v[8];
#pragma unroll
                        for (int e = 0; e < 8; ++e) { const float x = acc[ai][bj][m][e >> 2][e & 3]; const float s = sigmoidf_(x); v[e] = op == 0 ? x : (op == 1 ? x * s : s); }
                        u32x4 w; w.x = cvt_pk_bf16(v[0], v[1]); w.y = cvt_pk_bf16(v[2], v[3]); w.z = cvt_pk_bf16(v[4], v[5]); w.w = cvt_pk_bf16(v[6], v[7]);
                        *(u32x4*)(dst + (size_t)r * ld + cb + bj * 128) = w; } }
        }
    }
};
template <int PASS> struct EpiProj {
    static constexpr bool PERM = true, AFTER_DRAIN = false;
    unsigned char* ws;
    __device__ __forceinline__ void operator()(const f32x4 (&acc)[2][2][4][2], const Unit& u, int wr, int wc, int fr, int fq) const {
        const int row0 = u.pm * 256 + wr * 64 + fr, col0 = u.pn * 256 + wc * 32 + 8 * fq;
        const bf16_t* mg = (const bf16_t*)(ws + WS_MG) + (PASS ? 1024 : 0); float* zf = (float*)(ws + WS_UT); bf16_t* z = (bf16_t*)(ws + WS_VR);
#pragma unroll
        for (int ai = 0; ai < 2; ++ai)
#pragma unroll
            for (int m = 0; m < 4; ++m) { const int r = row0 + ai * 128 + m * 16;
#pragma unroll
                for (int bj = 0; bj < 2; ++bj) { const int c = col0 + bj * 128;
                    const u32x4 g = *(const u32x4*)(mg + (size_t)r * 2048 + c);
                    const f32x4 a0 = acc[ai][bj][m][0], a1 = acc[ai][bj][m][1];
                    f32x4 t0, t1;
                    t0[0] = a0[0] * bf_lo(g.x); t0[1] = a0[1] * bf_hi(g.x); t0[2] = a0[2] * bf_lo(g.y); t0[3] = a0[3] * bf_hi(g.y);
                    t1[0] = a1[0] * bf_lo(g.z); t1[1] = a1[1] * bf_hi(g.z); t1[2] = a1[2] * bf_lo(g.w); t1[3] = a1[3] * bf_hi(g.w);
                    float* zp = zf + (size_t)r * 1024 + c;
                    if (PASS == 0) { *(f32x4*)zp = t0; *(f32x4*)(zp + 4) = t1; }
                    else { const f32x4 p0 = *(const f32x4*)zp, p1 = *(const f32x4*)(zp + 4); t0 += p0; t1 += p1;
                        u32x4 w; w.x = cvt_pk_bf16(t0[0], t0[1]); w.y = cvt_pk_bf16(t0[2], t0[3]); w.z = cvt_pk_bf16(t1[0], t1[1]); w.w = cvt_pk_bf16(t1[2], t1[3]);
                        *(u32x4*)(z + (size_t)r * 1024 + c) = w; } } }
    }
};
struct EpiOut {
    static constexpr bool PERM = false, AFTER_DRAIN = false;
    const float* x; const float* gate; float* vpre;
    __device__ __forceinline__ void operator()(const f32x4 (&acc)[2][2][4][2], const Unit& u, int wr, int wc, int fr, int fq) const {
        const int row0 = u.pm * 256 + wr * 64 + fr, col0 = u.pn * 256 + wc * 32 + 4 * fq;
        f32x4 gv[2][2];
#pragma unroll
        for (int bj = 0; bj < 2; ++bj)
#pragma unroll
            for (int n = 0; n < 2; ++n) gv[bj][n] = *(const f32x4*)(gate + col0 + bj * 128 + n * 16);
#pragma unroll
        for (int ai = 0; ai < 2; ++ai)
#pragma unroll
            for (int m = 0; m < 4; ++m) { const size_t off = (size_t)(row0 + ai * 128 + m * 16) * 1024 + col0;
#pragma unroll
                for (int bj = 0; bj < 2; ++bj)
#pragma unroll
                    for (int n = 0; n < 2; ++n) { const f32x4 xv = *(const f32x4*)(x + off + bj * 128 + n * 16);
                        *(f32x4*)(vpre + off + bj * 128 + n * 16) = xv * ALPHA_F + gv[bj][n] * acc[ai][bj][m][n]; } }
    }
};

__device__ __forceinline__ int win_logical(int pg) {
    const int pn = pg >> 3, bj = (pg >> 2) & 1, wq = pg & 3;
    if (pn <= 1) return pn * 256 + wq * 64 + bj * 32;
    if (pn == 2) return wq < 2 ? 512 + wq * 64 + bj * 32 : 640 + bj * 64 + (wq - 2) * 32;
    if (pn >= 5 && pn <= 6) return 1280 + (pn - 5) * 256 + (wq >> 1) * 128 + bj * 64 + (wq & 1) * 32;
    if (pn >= 7 && pn <= 8) return 1792 + (pn - 7) * 256 + (wq >> 1) * 128 + bj * 64 + (wq & 1) * 32;
    return pg * 32;
}
__device__ __forceinline__ void xpose_tile(const float* src, int ldn, bf16_t* dst, int K, int p0, int k0, int lcol, float* tile) {
    const int tid = opq(threadIdx.x);
    { const int c = tid & 31, kr = tid >> 5;
#pragma unroll
      for (int ps = 0; ps < 8; ++ps) { const int k = kr + 16 * ps; tile[k * 33 + c] = src[(size_t)(k0 + k) * ldn + lcol + c]; } }
    __syncthreads();
    { const int p = tid >> 4, ks = (tid & 15) * 8; float v[8];
#pragma unroll
      for (int e = 0; e < 8; ++e) v[e] = tile[(ks + e) * 33 + p];
      u32x4 w; w.x = cvt_pk_bf16(v[0], v[1]); w.y = cvt_pk_bf16(v[2], v[3]); w.z = cvt_pk_bf16(v[4], v[5]); w.w = cvt_pk_bf16(v[6], v[7]);
      *(u32x4*)(dst + (size_t)(p0 + p) * K + k0 + ks) = w; }
    __syncthreads();
}
__device__ __forceinline__ void phase0(const Params& P, float* tile) {
    unsigned char* ws = P.ws;
    for (int it = blockIdx.x; it < 2 * 3008; it += gridDim.x) {
        const int l = it / 3008; int t = it % 3008;
        if (t < 1600) { const int pg = t >> 3, kt = t & 7; xpose_tile(P.w_in + (size_t)l * DM * NIN, NIN, (bf16_t*)(ws + WS_WIN) + (size_t)l * NIN * DM, 1024, pg * 32, kt * 128, win_logical(pg), tile); }
        else if ((t -= 1600) < 768) { const int pg = t >> 3, kt = t & 7; xpose_tile(P.w_cond + (size_t)l * DM * 3072, 3072, (bf16_t*)(ws + WS_WC) + (size_t)l * 3072 * DM, 1024, pg * 32, kt * 128, pg * 32, tile); }
        else if ((t -= 768) < 128) { const int pg = t >> 2, kt = t & 3; xpose_tile(P.w_pa + (size_t)l * 512 * DM, 1024, (bf16_t*)(ws + WS_WPA) + (size_t)l * 1024 * 512, 512, pg * 32, kt * 128, pg * 32, tile); }
        else if ((t -= 128) < 256) { const int pg = t >> 3, kt = t & 7; xpose_tile(P.w_pr + (size_t)l * DM * DM, 1024, (bf16_t*)(ws + WS_WPR) + (size_t)l * DM * DM, 1024, pg * 32, kt * 128, pg * 32, tile); }
        else { t -= 256; const int pg = t >> 3, kt = t & 7; xpose_tile(P.w_out + (size_t)l * DM * DM, 1024, (bf16_t*)(ws + WS_WOUT) + (size_t)l * DM * DM, 1024, pg * 32, kt * 128, pg * 32, tile); }
    }
    const size_t gtid = (size_t)blockIdx.x * 512 + opq(threadIdx.x), gsz = (size_t)gridDim.x * 512;
    for (size_t e = gtid; e < (size_t)16385 * 96; e += gsz) { const int pos = (int)(e / 96), i = (int)(e % 96);
        const bool a = i < 32; const int ii = a ? i : i - 32; const float half = a ? 32.0f : 64.0f;
        const float freq = powf(10000.0f, -(float)ii / half); const float ang = (float)pos * freq;
        const float c = cosf(ang), s = sinf(ang);
        float* d = a ? (float*)(ws + WS_ROPEA) + ((size_t)pos * 32 + ii) * 2 : (float*)(ws + WS_ROPER) + ((size_t)pos * 64 + ii) * 2;
        d[0] = c; d[1] = s; }
    for (size_t e = gtid; e < (size_t)256 * 1024; e += gsz) { const int r = (int)(e >> 10), k = (int)(e & 1023);
        float v = 0.f; if (r < 128) v = P.c_sample[(size_t)r * 1024 + k]; else if (r == 128) v = P.c_prompt[k];
        v = v * sigmoidf_(v); ((bf16_t*)(ws + WS_ACOND))[e] = (bf16_t)(cvt_pk_bf16(v, 0.f) & 0xffffu); }
}

__device__ __forceinline__ void phase_hprep(const Params& P) {
    const float* mod = (const float*)(P.ws + WS_MOD); bf16_t* H = (bf16_t*)(P.ws + WS_H);
    for (size_t e = (size_t)blockIdx.x * 512 + opq(threadIdx.x); e < (size_t)MPAD * 128; e += (size_t)gridDim.x * 512) {
        const int r = (int)(e >> 7), c = (int)(e & 127) * 8; u32x4 w = {0u, 0u, 0u, 0u};
        if (r < MREAL) { const float* x = r < LP ? P.x_prompt + (size_t)r * 1024 + c : P.x_sample + (size_t)(r - LP) * 1024 + c;
            const float* mr = mod + (size_t)(r < LP ? 128 : r - LP) * 6144;
            const f32x4 x0 = *(const f32x4*)x, x1 = *(const f32x4*)(x + 4), sh0 = *(const f32x4*)(mr + c), sh1 = *(const f32x4*)(mr + c + 4), sc0 = *(const f32x4*)(mr + 1024 + c), sc1 = *(const f32x4*)(mr + 1024 + c + 4);
            const f32x4 h0 = x0 * (sc0 + 1.0f) + sh0, h1 = x1 * (sc1 + 1.0f) + sh1;
            w.x = cvt_pk_bf16(h0[0], h0[1]); w.y = cvt_pk_bf16(h0[2], h0[3]); w.z = cvt_pk_bf16(h1[0], h1[1]); w.w = cvt_pk_bf16(h1[2], h1[3]); }
        *(u32x4*)(H + (size_t)r * 1024 + c) = w; }
}

__device__ __forceinline__ void attn_prompt_item(const Params& P, int l, int n, int g, unsigned char* lds, bf16_t* OAd) {
    bf16_t* Ks = (bf16_t*)lds; bf16_t* Vt = Ks + 256 * 72;
    const bf16_t* KA = (const bf16_t*)(P.ws + WS_KA); const bf16_t* VA = (const bf16_t*)(P.ws + WS_VA); const bf16_t* GA = (const bf16_t*)(P.ws + WS_GA); bf16_t* QA = (bf16_t*)(P.ws + WS_QA);
    const int tid = opq(threadIdx.x), lane = tid & 63, w = tid >> 6, fr = lane & 15, fq = lane >> 4;
    const int krow0 = (n - 1) * 128;
    for (int c = tid; c < 2048; c += 512) { const int key = c >> 3, ch = c & 7; const int row = krow0 + key; u32x4 v = {0u, 0u, 0u, 0u};
        if (row >= 0) v = *(const u32x4*)(KA + (size_t)row * 128 + g * 64 + ch * 8);
        *(u32x4*)(Ks + key * 72 + ch * 8) = v; }
    { const int key = tid & 255, c0 = (tid >> 8) * 4; const int row = krow0 + key;
#pragma unroll
      for (int i = 0; i < 4; ++i) { const int ch = c0 + i; u32x4 v = {0u, 0u, 0u, 0u};
          if (row >= 0) v = *(const u32x4*)(VA + (size_t)row * 128 + g * 64 + ch * 8);
#pragma unroll
          for (int e = 0; e < 4; ++e) { Vt[(ch * 8 + 2 * e) * 264 + key] = (bf16_t)(v[e] & 0xffffu); Vt[(ch * 8 + 2 * e + 1) * 264 + key] = (bf16_t)(v[e] >> 16); } } }
    __syncthreads();
    const int hq = g * 4 + (w >> 1), qi0 = (w & 1) * 64;
    const float sink = P.sinks[l * 8 + hq];
    for (int qb = 0; qb < 4; ++qb) {
        const int qi = qi0 + qb * 16 + fr; const size_t qrow = (size_t)n * 128 + qi;
        const bf16x8 q0 = *(const bf16x8*)(QA + qrow * 512 + hq * 64 + fq * 8), q1 = *(const bf16x8*)(QA + qrow * 512 + hq * 64 + 32 + fq * 8);
        const int kbs = ((qi0 >> 4) + qb) & ~1;
        f32x4 s[10];
#pragma unroll
        for (int kk = 0; kk < 10; ++kk) { const bf16_t* kp = Ks + ((kbs + kk) * 16 + fr) * 72 + fq * 8;
            const bf16x8 k0 = *(const bf16x8*)kp, k1 = *(const bf16x8*)(kp + 32);
            s[kk] = mfma16(k0, q0, (f32x4){0.f, 0.f, 0.f, 0.f}); s[kk] = mfma16(k1, q1, s[kk]); }
        float mx = sink;
#pragma unroll
        for (int kk = 0; kk < 10; ++kk)
#pragma unroll
            for (int j = 0; j < 4; ++j) { const int key = (kbs + kk) * 16 + fq * 4 + j; const bool ok = key >= qi && key <= qi + 128 && (n > 0 || key >= 128);
                s[kk][j] = ok ? s[kk][j] : -INFINITY; mx = fmaxf(mx, s[kk][j]); }
        mx = fmaxf(mx, __shfl_xor(mx, 16)); mx = fmaxf(mx, __shfl_xor(mx, 32));
        float sum = 0.f;
#pragma unroll
        for (int kk = 0; kk < 10; ++kk)
#pragma unroll
            for (int j = 0; j < 4; ++j) { const float p = __expf(s[kk][j] - mx); s[kk][j] = p; sum += p; }
        sum += __shfl_xor(sum, 16); sum += __shfl_xor(sum, 32);
        const float inv = 1.0f / (sum + __expf(sink - mx));
        f32x4 o[4];
#pragma unroll
        for (int db = 0; db < 4; ++db) o[db] = (f32x4){0.f, 0.f, 0.f, 0.f};
#pragma unroll
        for (int ss = 0; ss < 5; ++ss) { const bf16x8 pf = pack8(s[2 * ss], s[2 * ss + 1]);
#pragma unroll
            for (int db = 0; db < 4; ++db) { const bf16_t* vp = Vt + (db * 16 + fr) * 264 + kbs * 16 + 32 * ss + fq * 4;
                const bf16x8 vf = cat44(*(const bf16x4*)vp, *(const bf16x4*)(vp + 16));
                o[db] = mfma16(vf, pf, o[db]); } }
#pragma unroll
        for (int db = 0; db < 4; ++db) { const size_t off = qrow * 512 + hq * 64 + db * 16 + fq * 4;
            const u32x2 gv = *(const u32x2*)(GA + off); u32x2 wv;
            wv.x = cvt_pk_bf16(o[db][0] * inv * bf_lo(gv.x), o[db][1] * inv * bf_hi(gv.x)); wv.y = cvt_pk_bf16(o[db][2] * inv * bf_lo(gv.y), o[db][3] * inv * bf_hi(gv.y));
            *(u32x2*)(OAd + off) = wv; }
    }
    __syncthreads();
}
__device__ __forceinline__ void attn_sample_item(const Params& P, int l, int b, int g, unsigned char* lds, bf16_t* OAd) {
    float* Kc = (float*)lds; float* Vc = Kc + 128 * 65; float* qs = Vc + 128 * 65; float* sc = qs + 256; float* kn = sc + 4 * 132; float* vn = kn + 64;
    const bf16_t* KA = (const bf16_t*)(P.ws + WS_KA); const bf16_t* VA = (const bf16_t*)(P.ws + WS_VA); const bf16_t* GA = (const bf16_t*)(P.ws + WS_GA); bf16_t* QA = (bf16_t*)(P.ws + WS_QA);
    const int tid = opq(threadIdx.x), lane = tid & 63, w = tid >> 6; const size_t row = (size_t)LP + b;
    const size_t cb = ((size_t)(l * 128 + b) * 128) * 128 + g * 64;
    const float* ck = P.cache_k + cb; const float* cv = P.cache_v + cb; float* nk = P.out + O_NKS + cb; float* nv = P.out + O_NVS + cb;
    for (int i = tid; i < 2048; i += 512) { const int kw = i >> 4, c4 = (i & 15) * 4;
        const f32x4 kv = *(const f32x4*)(ck + (size_t)kw * 128 + c4), vv = *(const f32x4*)(cv + (size_t)kw * 128 + c4);
#pragma unroll
        for (int e = 0; e < 4; ++e) { Kc[kw * 65 + c4 + e] = kv[e]; Vc[kw * 65 + c4 + e] = vv[e]; }
        if (kw > 0) { *(f32x4*)(nk + (size_t)(kw - 1) * 128 + c4) = kv; *(f32x4*)(nv + (size_t)(kw - 1) * 128 + c4) = vv; } }
    if (tid < 256) qs[tid] = bf1(QA[row * 512 + g * 256 + tid]);
    else if (tid < 320) kn[tid - 256] = bf1(KA[row * 128 + g * 64 + (tid - 256)]);
    else if (tid < 384) vn[tid - 320] = bf1(VA[row * 128 + g * 64 + (tid - 320)]);
    __syncthreads();
    { const int qh = tid >> 7, kw = tid & 127; float a = 0.f;
#pragma unroll 16
      for (int d = 0; d < 64; ++d) a += qs[qh * 64 + d] * Kc[kw * 65 + d];
      sc[qh * 132 + kw] = a;
      if (tid < 4) { float a2 = 0.f; for (int d = 0; d < 64; ++d) a2 += qs[tid * 64 + d] * kn[d]; sc[tid * 132 + 128] = a2; } }
    __syncthreads();
    if (w < 4) { const float sink = P.sinks[l * 8 + g * 4 + w];
        const float v0 = sc[w * 132 + lane], v1 = sc[w * 132 + 64 + lane], v2 = lane == 0 ? sc[w * 132 + 128] : -INFINITY;
        float mx = fmaxf(fmaxf(v0, v1), fmaxf(v2, sink));
#pragma unroll
        for (int o = 1; o < 64; o <<= 1) mx = fmaxf(mx, __shfl_xor(mx, o));
        const float p0 = __expf(v0 - mx), p1 = __expf(v1 - mx), p2 = __expf(v2 - mx); float sum = p0 + p1 + p2;
#pragma unroll
        for (int o = 1; o < 64; o <<= 1) sum += __shfl_xor(sum, o);
        const float inv = 1.0f / (sum + __expf(sink - mx));
        sc[w * 132 + lane] = p0 * inv; sc[w * 132 + 64 + lane] = p1 * inv; if (lane == 0) sc[w * 132 + 128] = p2 * inv; }
    __syncthreads();
    { const int qh = tid >> 7, d = (tid & 127) >> 1, hf = tid & 1; float a = 0.f;
#pragma unroll 16
      for (int kw = hf * 64; kw < hf * 64 + 64; ++kw) a += sc[qh * 132 + kw] * Vc[kw * 65 + d];
      a += __shfl_xor(a, 1);
      if (hf == 0) { a += sc[qh * 132 + 128] * vn[d]; const size_t off = row * 512 + (g * 4 + qh) * 64 + d;
          OAd[off] = (bf16_t)(cvt_pk_bf16(a * bf1(GA[off]), 0.f) & 0xffffu); } }
    __syncthreads();
}
__device__ __forceinline__ void load_vt(const bf16_t* VR, int n, int h, bf16_t* Vt) {
    const int tidv = opq(threadIdx.x); const int tok = tidv & 127, c0 = (tidv >> 7) * 8; const size_t row = (size_t)n * 128 + tok;
#pragma unroll
    for (int i = 0; i < 8; ++i) { const int ch = c0 + i; const u32x4 v = *(const u32x4*)(VR + row * 1024 + h * 256 + ch * 8);
#pragma unroll
        for (int e = 0; e < 4; ++e) { Vt[(ch * 8 + 2 * e) * 136 + tok] = (bf16_t)(v[e] & 0xffffu); Vt[(ch * 8 + 2 * e + 1) * 136 + tok] = (bf16_t)(v[e] >> 16); } }
}
__device__ __forceinline__ void ret_u_item(const Params& P, int n, int h, unsigned char* lds) {
    bf16_t* Kt = (bf16_t*)lds; bf16_t* Vt = Kt + 128 * 136;
    const bf16_t* KR = (const bf16_t*)(P.ws + WS_KR); const bf16_t* VR = (const bf16_t*)(P.ws + WS_VR); float* UT = (float*)(P.ws + WS_UT);
    const int tid = opq(threadIdx.x), lane = tid & 63, w = tid >> 6, fr = lane & 15, fq = lane >> 4;
    const float l2g = log2gamma(h);
    { const int tok = tid & 127, c0 = (tid >> 7) * 4; const size_t row = (size_t)n * 128 + tok; const float dec = exp2f((float)(127 - tok) * l2g);
#pragma unroll
      for (int i = 0; i < 4; ++i) { const int ch = c0 + i; const u32x4 v = *(const u32x4*)(KR + row * 512 + h * 128 + ch * 8);
#pragma unroll
          for (int e = 0; e < 4; ++e) { const unsigned pk = cvt_pk_bf16(bf_lo(v[e]) * dec, bf_hi(v[e]) * dec);
              Kt[(ch * 8 + 2 * e) * 136 + tok] = (bf16_t)(pk & 0xffffu); Kt[(ch * 8 + 2 * e + 1) * 136 + tok] = (bf16_t)(pk >> 16); } } }
    load_vt(VR, n, h, Vt);
    __syncthreads();
    f32x4 acc[2][8];
#pragma unroll
    for (int a = 0; a < 2; ++a)
#pragma unroll
        for (int b = 0; b < 8; ++b) acc[a][b] = (f32x4){0.f, 0.f, 0.f, 0.f};
#pragma unroll
    for (int ks = 0; ks < 4; ++ks) { bf16x8 vf[2];
#pragma unroll
        for (int vb = 0; vb < 2; ++vb) vf[vb] = *(const bf16x8*)(Vt + (32 * w + 16 * vb + fr) * 136 + ks * 32 + fq * 8);
#pragma unroll
        for (int kb = 0; kb < 8; ++kb) { const bf16x8 kf = *(const bf16x8*)(Kt + (16 * kb + fr) * 136 + ks * 32 + fq * 8);
#pragma unroll
            for (int vb = 0; vb < 2; ++vb) acc[vb][kb] = mfma16(kf, vf[vb], acc[vb][kb]); } }
#pragma unroll
    for (int vb = 0; vb < 2; ++vb)
#pragma unroll
        for (int kb = 0; kb < 8; ++kb) *(f32x4*)(UT + ((size_t)(n * 4 + h) * 256 + 32 * w + 16 * vb + fr) * 128 + 16 * kb + fq * 4) = acc[vb][kb];
    __syncthreads();
}
__device__ __forceinline__ void ret_sample_item(const Params& P, int l, int b, int h, unsigned char* lds, bf16_t* ORd) {
    float* red = (float*)lds; float* ssum = red + 2048;
    const bf16_t* QR = (const bf16_t*)(P.ws + WS_QR); const bf16_t* KR = (const bf16_t*)(P.ws + WS_KR); const bf16_t* VR = (const bf16_t*)(P.ws + WS_VR); bf16_t* GR = (bf16_t*)(P.ws + WS_GR);
    const int tid = opq(threadIdx.x), lane = tid & 63, w = tid >> 6; const size_t row = (size_t)LP + b;
    const float gam = 1.0f - exp2f(-5.0f - (float)h);
    const u32x2 vraw = *(const u32x2*)(VR + row * 1024 + h * 256 + lane * 4);
    const f32x4 v = {bf_lo(vraw.x), bf_hi(vraw.x), bf_lo(vraw.y), bf_hi(vraw.y)};
    const size_t sb = ((size_t)(l * 128 + b) * 4 + h) * 128 * 256;
    const float* S = P.state_ret + sb; float* SN = P.out + O_NSS + sb;
    f32x4 o = {0.f, 0.f, 0.f, 0.f};
    f32x4 sv[16];
#pragma unroll
    for (int i = 0; i < 16; ++i) sv[i] = __builtin_nontemporal_load((const f32x4*)(S + (size_t)(w + 8 * i) * 256 + lane * 4));
#pragma unroll
    for (int i = 0; i < 16; ++i) { const int dk = w + 8 * i; const float q = bf1(QR[row * 512 + h * 128 + dk]), k = bf1(KR[row * 512 + h * 128 + dk]);
        const f32x4 sn = sv[i] * gam + v * k;
        __builtin_nontemporal_store(sn, (f32x4*)(SN + (size_t)dk * 256 + lane * 4)); o += sn * q; }
    *(f32x4*)(red + w * 256 + lane * 4) = o;
    __syncthreads();
    float tot = 0.f;
    if (tid < 256) {
#pragma unroll
        for (int i = 0; i < 8; ++i) tot += red[i * 256 + tid];
        float sq = tot * tot;
#pragma unroll
        for (int of = 1; of < 64; of <<= 1) sq += __shfl_xor(sq, of);
        if (lane == 0) ssum[w] = sq; }
    __syncthreads();
    if (tid < 256) { const float total = ssum[0] + ssum[1] + ssum[2] + ssum[3]; const float rinv = rsqrtf(total * (1.0f / 256.0f) + 1e-6f);
        const size_t off = row * 1024 + h * 256 + tid; ORd[off] = (bf16_t)(cvt_pk_bf16(tot * rinv * bf1(GR[off]), 0.f) & 0xffffu); }
    __syncthreads();
}
__device__ __forceinline__ void ret_o_item(const Params& P, int n, int h, unsigned char* lds, bf16_t* ORd) {
    bf16_t* Ks = (bf16_t*)lds; bf16_t* Vt = Ks + 128 * 136; float* red = (float*)(Vt + 256 * 136);
    const bf16_t* QR = (const bf16_t*)(P.ws + WS_QR); const bf16_t* KR = (const bf16_t*)(P.ws + WS_KR); const bf16_t* VR = (const bf16_t*)(P.ws + WS_VR); bf16_t* GR = (bf16_t*)(P.ws + WS_GR);
    const bf16_t* ST = (const bf16_t*)(P.ws + WS_ST);
    const int tid = opq(threadIdx.x), lane = tid & 63, w = tid >> 6, fr = lane & 15, fq = lane >> 4;
    const float l2g = log2gamma(h);
    { const int r = tid >> 2, c0 = (tid & 3) * 4;
#pragma unroll
      for (int i = 0; i < 4; ++i) *(u32x4*)(Ks + r * 136 + (c0 + i) * 8) = *(const u32x4*)(KR + ((size_t)n * 128 + r) * 512 + h * 128 + (c0 + i) * 8); }
    load_vt(VR, n, h, Vt);
    __syncthreads();
    const int tg = w >> 1, dh = w & 1;
    bf16x8 qf[2][4];
#pragma unroll
    for (int qb = 0; qb < 2; ++qb)
#pragma unroll
        for (int ks = 0; ks < 4; ++ks) qf[qb][ks] = *(const bf16x8*)(QR + ((size_t)n * 128 + 32 * tg + 16 * qb + fr) * 512 + h * 128 + ks * 32 + fq * 8);
    f32x4 acc[8][2];
#pragma unroll
    for (int a = 0; a < 8; ++a)
#pragma unroll
        for (int b = 0; b < 2; ++b) acc[a][b] = (f32x4){0.f, 0.f, 0.f, 0.f};
    { const bf16_t* Sb = ST + ((size_t)(n * 4 + h) * 256 + 128 * dh) * 128;
#pragma unroll
      for (int ks = 0; ks < 4; ++ks)
#pragma unroll
          for (int dvb = 0; dvb < 8; ++dvb) { const bf16x8 sf = *(const bf16x8*)(Sb + (size_t)(16 * dvb + fr) * 128 + ks * 32 + fq * 8);
#pragma unroll
              for (int qb = 0; qb < 2; ++qb) acc[dvb][qb] = mfma16(sf, qf[qb][ks], acc[dvb][qb]); } }
#pragma unroll
    for (int s = 0; s < 4; ++s) if (s <= tg) {
        f32x4 in[2][2];
#pragma unroll
        for (int k2 = 0; k2 < 2; ++k2) { in[k2][0] = (f32x4){0.f, 0.f, 0.f, 0.f}; in[k2][1] = (f32x4){0.f, 0.f, 0.f, 0.f};
#pragma unroll
            for (int ks = 0; ks < 4; ++ks) { const bf16x8 kf = *(const bf16x8*)(Ks + (16 * (2 * s + k2) + fr) * 136 + ks * 32 + fq * 8);
#pragma unroll
                for (int qb = 0; qb < 2; ++qb) in[k2][qb] = mfma16(kf, qf[qb][ks], in[k2][qb]); } }
#pragma unroll
        for (int k2 = 0; k2 < 2; ++k2)
#pragma unroll
            for (int j = 0; j < 4; ++j) { const int key = 16 * (2 * s + k2) + fq * 4 + j; const float f = exp2f(-(float)(key + 1) * l2g);
#pragma unroll
                for (int qb = 0; qb < 2; ++qb) { const int i = 32 * tg + 16 * qb + fr; in[k2][qb][j] = key <= i ? in[k2][qb][j] * f : 0.f; } }
        bf16x8 pf[2];
#pragma unroll
        for (int qb = 0; qb < 2; ++qb) pf[qb] = pack8(in[0][qb], in[1][qb]);
#pragma unroll
        for (int dvb = 0; dvb < 8; ++dvb) { const bf16_t* vp = Vt + (128 * dh + 16 * dvb + fr) * 136 + 32 * s + fq * 4;
            const bf16x8 vf = cat44(*(const bf16x4*)vp, *(const bf16x4*)(vp + 16));
#pragma unroll
            for (int qb = 0; qb < 2; ++qb) acc[dvb][qb] = mfma16(vf, pf[qb], acc[dvb][qb]); }
    }
#pragma unroll
    for (int qb = 0; qb < 2; ++qb) { const int i = 32 * tg + 16 * qb + fr; const float scl = exp2f((float)(i + 1) * l2g); float ss = 0.f;
#pragma unroll
        for (int dvb = 0; dvb < 8; ++dvb) { acc[dvb][qb] *= scl;
#pragma unroll
            for (int j = 0; j < 4; ++j) ss += acc[dvb][qb][j] * acc[dvb][qb][j]; }
        ss += __shfl_xor(ss, 16); ss += __shfl_xor(ss, 32);
        if (fq == 0) red[dh * 128 + i] = ss; }
    __syncthreads();
#pragma unroll
    for (int qb = 0; qb < 2; ++qb) { const int i = 32 * tg + 16 * qb + fr; const float rinv = rsqrtf((red[i] + red[128 + i]) * (1.0f / 256.0f) + 1e-6f);
#pragma unroll
        for (int dvb = 0; dvb < 8; ++dvb) { const size_t off = ((size_t)n * 128 + i) * 1024 + h * 256 + 128 * dh + 16 * dvb + fq * 4;
            const u32x2 gv = *(const u32x2*)(GR + off); const f32x4 a = acc[dvb][qb] * rinv; u32x2 wv;
            wv.x = cvt_pk_bf16(a[0] * bf_lo(gv.x), a[1] * bf_hi(gv.x)); wv.y = cvt_pk_bf16(a[2] * bf_lo(gv.y), a[3] * bf_hi(gv.y));
            *(u32x2*)(ORd + off) = wv; } }
    __syncthreads();
}
__device__ __forceinline__ void phase_scan(const Params& P, int l) {
    const float* UT = (const float*)(P.ws + WS_UT); bf16_t* ST = (bf16_t*)(P.ws + WS_ST);
    for (int e = blockIdx.x * 512 + opq(threadIdx.x); e < 131072; e += gridDim.x * 512) {
        const int h = e >> 15, dv = (e >> 7) & 255, dk = e & 127;
        const float dec = __expf(128.0f * __logf(1.0f - exp2f(-5.0f - (float)h)));
        float S = 0.f;
        for (int n0 = 0; n0 < 128; n0 += 16) { float u[16];
#pragma unroll
            for (int i = 0; i < 16; ++i) u[i] = UT[(size_t)(n0 + i) * 131072 + e];
#pragma unroll
            for (int i = 0; i < 16; ++i) { ST[(size_t)(n0 + i) * 131072 + e] = (bf16_t)(cvt_pk_bf16(S, 0.f) & 0xffffu); S = S * dec + u[i]; } }
        P.out[O_NSP + (size_t)l * 131072 + ((size_t)h * 128 + dk) * 256 + dv] = S; }
}
__device__ __forceinline__ f32x4 small_acc(const bf16_t* ap, const bf16_t* bp, int K) {
    f32x4 acc = {0.f, 0.f, 0.f, 0.f};
#pragma unroll 8
    for (int ks = 0; ks < K / 32; ++ks) acc = mfma16(*(const bf16x8*)(bp + ks * 32), *(const bf16x8*)(ap + ks * 32), acc);
    return acc;
}
__device__ __forceinline__ void proj_sample(const Params& P, int l) {
    if (blockIdx.x >= 64) return;
    const int tidv = opq(threadIdx.x); const int lane = tidv & 63, w = tidv >> 6, fr = lane & 15, fq = lane >> 4;
    const size_t row = (size_t)LP + 16 * w + fr; const int colb = 16 * blockIdx.x + fr, c0 = 16 * blockIdx.x + 4 * fq;
    const f32x4 za = small_acc((const bf16_t*)(P.ws + WS_QA) + row * 512 + fq * 8, (const bf16_t*)(P.ws + WS_WPA) + (size_t)l * 1024 * 512 + (size_t)colb * 512 + fq * 8, 512);
    const f32x4 zr = small_acc((const bf16_t*)(P.ws + WS_GR) + row * 1024 + fq * 8, (const bf16_t*)(P.ws + WS_WPR) + (size_t)l * 1024 * 1024 + (size_t)colb * 1024 + fq * 8, 1024);
    const bf16_t* mg = (const bf16_t*)(P.ws + WS_MG) + row * 2048 + c0; const u32x2 ga = *(const u32x2*)mg, gr = *(const u32x2*)(mg + 1024);
    u32x2 wv; wv.x = cvt_pk_bf16(za[0] * bf_lo(ga.x) + zr[0] * bf_lo(gr.x), za[1] * bf_hi(ga.x) + zr[1] * bf_hi(gr.x));
    wv.y = cvt_pk_bf16(za[2] * bf_lo(ga.y) + zr[2] * bf_lo(gr.y), za[3] * bf_hi(ga.y) + zr[3] * bf_hi(gr.y));
    *(u32x2*)((bf16_t*)(P.ws + WS_VR) + row * 1024 + c0) = wv;
}
__device__ __forceinline__ void out_sample(const Params& P, int l, const float* xs) {
    if (blockIdx.x >= 64) return;
    const int tidv = opq(threadIdx.x); const int lane = tidv & 63, w = tidv >> 6, fr = lane & 15, fq = lane >> 4;
    const int b = 16 * w + fr; const size_t row = (size_t)LP + b; const int colb = 16 * blockIdx.x + fr, c0 = 16 * blockIdx.x + 4 * fq;
    const f32x4 a = small_acc((const bf16_t*)(P.ws + WS_VR) + row * 1024 + fq * 8, (const bf16_t*)(P.ws + WS_WOUT) + (size_t)l * 1024 * 1024 + (size_t)colb * 1024 + fq * 8, 1024);
    const f32x4 gate = *(const f32x4*)((const float*)(P.ws + WS_MOD) + (size_t)b * 6144 + l * 3072 + 2048 + c0);
    const f32x4 xv = *(const f32x4*)(xs + (size_t)b * 1024 + c0);
    *(f32x4*)((float*)(P.ws + WS_MG) + row * 1024 + c0) = xv * ALPHA_F + gate * a;
}
__device__ __forceinline__ void phase_ln(const Params& P, int l) {
    const float* vpre = (const float*)(P.ws + WS_MG); const float* g = P.ln_g + l * 1024; const float* bb = P.ln_b + l * 1024;
    const float* mod = (const float*)(P.ws + WS_MOD); bf16_t* H = (bf16_t*)(P.ws + WS_H); float* X1 = (float*)(P.ws + WS_X1);
    const int tidv = opq(threadIdx.x); const int lane = tidv & 63, w = tidv >> 6;
    for (int r = blockIdx.x * 8 + w; r < MREAL; r += gridDim.x * 8) {
        const float* v = vpre + (size_t)r * 1024; f32x4 a[4]; float s = 0.f;
#pragma unroll
        for (int i = 0; i < 4; ++i) { a[i] = *(const f32x4*)(v + i * 256 + lane * 4); s += a[i][0] + a[i][1] + a[i][2] + a[i][3]; }
#pragma unroll
        for (int of = 1; of < 64; of <<= 1) s += __shfl_xor(s, of);
        const float mu = s * (1.0f / 1024.0f); float q = 0.f;
#pragma unroll
        for (int i = 0; i < 4; ++i) { a[i] -= mu; q += a[i][0] * a[i][0] + a[i][1] * a[i][1] + a[i][2] * a[i][2] + a[i][3] * a[i][3]; }
#pragma unroll
        for (int of = 1; of < 64; of <<= 1) q += __shfl_xor(q, of);
        const float rstd = rsqrtf(q * (1.0f / 1024.0f) + 1e-5f);
        float* dst = l == 0 ? X1 + (size_t)r * 1024 : (r < LP ? P.out + O_YP + (size_t)r * 1024 : P.out + O_YS + (size_t)(r - LP) * 1024);
        const float* mr = mod + (size_t)(r < LP ? 128 : r - LP) * 6144 + 3072;
#pragma unroll
        for (int i = 0; i < 4; ++i) { const int c = i * 256 + lane * 4; const f32x4 y = a[i] * rstd * *(const f32x4*)(g + c) + *(const f32x4*)(bb + c);
            *(f32x4*)(dst + c) = y;
            if (l == 0) { const f32x4 hh = y * (*(const f32x4*)(mr + 1024 + c) + 1.0f) + *(const f32x4*)(mr + c); u32x2 wv; wv.x = cvt_pk_bf16(hh[0], hh[1]); wv.y = cvt_pk_bf16(hh[2], hh[3]);
                *(u32x2*)(H + (size_t)r * 1024 + c) = wv; } }
    }
}

#ifndef REP_MASK
#define REP_MASK 0
#endif
#define NREP(bit) ((REP_MASK & (bit)) ? 2 : 1)
constexpr size_t WS_DUMMY = WS_END;
#define GSYNC() do { xcd_barrier(xb); if (REP_MASK & 256) xcd_barrier(xb); } while (0)
__global__ void __launch_bounds__(512, 2) fwd_megakernel(Params P) {
    extern __shared__ __attribute__((aligned(16))) unsigned char shm[];
    cg::grid_group grid = cg::this_grid();
    PG8_LAS unsigned char* lds3 = (PG8_LAS unsigned char*)shm;
    unsigned char* ws = P.ws;
    const int G = (int)gridDim.x, bid = (int)blockIdx.x;
    volatile LAS unsigned* xst = (volatile LAS unsigned*)(lds3 + 131072);
    if (threadIdx.x == 0) { xst[0] = 0u; xst[1] = 0u; }
    __syncthreads();
    const XcdBarrier xb = xcd_barrier_post((unsigned*)(ws + WS_BAR), xst);
    for (int rep = 0; rep < NREP(1); ++rep) phase0(P, (float*)shm);
    grid.sync();
    for (int rep = 0; rep < NREP(1); ++rep) {
        StaticOrder S; S.init(256, 6144, G, bid);
        pg8::EpiF32 E{(float*)(ws + WS_MOD), 6144, P.b_cond};
        pg8::gemm_phase<pg8::EpiF32, StaticOrder, false>(lds3, Gemm{(const bf16_t*)(ws + WS_ACOND), (const bf16_t*)(ws + WS_WC), 256, 6144, 1024}, S, E, nullptr);
    }
    GSYNC();
    for (int rep = 0; rep < NREP(1); ++rep) phase_hprep(P);
    GSYNC();
#pragma unroll 1
    for (int l = 0; l < NLAYER; ++l) {
        for (int rep = 0; rep < NREP(2); ++rep) {
            StaticOrder S; S.init(MPAD, NIN, G, bid);
            EpiIn E{l, ws, P.out};
            pg8::gemm_phase<EpiIn, StaticOrder, false>(lds3, Gemm{(const bf16_t*)(ws + WS_H), (const bf16_t*)(ws + WS_WIN) + (size_t)l * NIN * DM, MPAD, NIN, 1024}, S, E, nullptr);
        }
        GSYNC();
        for (int rep = 0; rep < NREP(4); ++rep) {
            const bool dry = rep + 1 < NREP(4);
            bf16_t* oad = dry ? (bf16_t*)(ws + WS_DUMMY) : (bf16_t*)(ws + WS_QA); bf16_t* ord = dry ? (bf16_t*)(ws + WS_DUMMY) : (bf16_t*)(ws + WS_GR);
#pragma unroll 1
            for (int it = bid; it < 1536; it += G) {
                if (it < 256) attn_prompt_item(P, l, it >> 1, it & 1, shm, oad);
                else if (it < 512) attn_sample_item(P, l, (it - 256) >> 1, it & 1, shm, oad);
                else if (it < 1024) ret_u_item(P, (it - 512) >> 2, it & 3, shm);
                else ret_sample_item(P, l, (it - 1024) >> 2, it & 3, shm, ord);
            }
        }
        GSYNC();
        for (int rep = 0; rep < NREP(8); ++rep) phase_scan(P, l);
        GSYNC();
        for (int rep = 0; rep < NREP(16); ++rep) {
            bf16_t* ord = (rep + 1 < NREP(16)) ? (bf16_t*)(ws + WS_DUMMY) : (bf16_t*)(ws + WS_GR);
#pragma unroll 1
            for (int it = bid; it < 512; it += G) ret_o_item(P, it >> 2, it & 3, shm, ord);
        }
        GSYNC();
        for (int rep = 0; rep < NREP(32); ++rep) {
            proj_sample(P, l);
            StaticOrder S; S.init(LP, 1024, G, bid);
            EpiProj<0> EA{ws}; EpiProj<1> EB{ws};
            pg8::gemm_phase<EpiProj<0>, StaticOrder, false>(lds3, Gemm{(const bf16_t*)(ws + WS_QA), (const bf16_t*)(ws + WS_WPA) + (size_t)l * 1024 * 512, LP, 1024, 512}, S, EA, nullptr);
            pg8::gemm_phase<EpiProj<1>, StaticOrder, false>(lds3, Gemm{(const bf16_t*)(ws + WS_GR), (const bf16_t*)(ws + WS_WPR) + (size_t)l * 1024 * 1024, LP, 1024, 1024}, S, EB, nullptr);
        }
        GSYNC();
        for (int rep = 0; rep < NREP(64); ++rep) {
            const float* xp = l == 0 ? P.x_prompt : (const float*)(ws + WS_X1);
            const float* xs = l == 0 ? P.x_sample : (const float*)(ws + WS_X1) + (size_t)LP * 1024;
            out_sample(P, l, xs);
            StaticOrder S; S.init(LP, 1024, G, bid);
            EpiOut E{xp, (const float*)(ws + WS_MOD) + (size_t)128 * 6144 + l * 3072 + 2048, (float*)(ws + WS_MG)};
            pg8::gemm_phase<EpiOut, StaticOrder, false>(lds3, Gemm{(const bf16_t*)(ws + WS_VR), (const bf16_t*)(ws + WS_WOUT) + (size_t)l * 1024 * 1024, LP, 1024, 1024}, S, E, nullptr);
        }
        GSYNC();
        for (int rep = 0; rep < NREP(128); ++rep) phase_ln(P, l);
        if (l + 1 < NLAYER) GSYNC();
    }
}

extern "C" void kernel_launch(void* const* d_in, const int* in_sizes, int n_in, void* d_out, int out_size, void* d_ws, size_t ws_size, hipStream_t stream) {
    static int grid = 0;
    if (grid == 0) {
        if (n_in != 16 || (size_t)out_size != O_END || ws_size < WS_END + (REP_MASK ? (size_t)36 << 20 : 0)) { fprintf(stderr, "kernel_launch: unexpected shapes (n_in %d out %d ws %zu need %zu)\n", n_in, out_size, ws_size, (size_t)WS_END); grid = -1; return; }
        int dev = 0, cus = 0, per_cu = 0;
        hipGetDevice(&dev); hipDeviceGetAttribute(&cus, hipDeviceAttributeMultiprocessorCount, dev);
        if (hipFuncSetAttribute((const void*)fwd_megakernel, hipFuncAttributeMaxDynamicSharedMemorySize, LDS_BYTES) != hipSuccess) { fprintf(stderr, "kernel_launch: hipFuncSetAttribute failed\n"); grid = -1; return; }
        if (hipOccupancyMaxActiveBlocksPerMultiprocessor(&per_cu, (const void*)fwd_megakernel, 512, LDS_BYTES) != hipSuccess || per_cu < 1) { fprintf(stderr, "kernel_launch: occupancy query says %d\n", per_cu); per_cu = 1; }
        (void)hipGetLastError();
        grid = cus;
    }
    if (grid < 0) return;
    Params p{};
    p.x_prompt = (const float*)d_in[0]; p.x_sample = (const float*)d_in[1]; p.c_prompt = (const float*)d_in[2]; p.c_sample = (const float*)d_in[3];
    p.cache_k = (const float*)d_in[4]; p.cache_v = (const float*)d_in[5]; p.state_ret = (const float*)d_in[6]; p.w_in = (const float*)d_in[7];
    p.sinks = (const float*)d_in[8]; p.w_cond = (const float*)d_in[9]; p.b_cond = (const float*)d_in[10]; p.w_pa = (const float*)d_in[11];
    p.w_pr = (const float*)d_in[12]; p.w_out = (const float*)d_in[13]; p.ln_g = (const float*)d_in[14]; p.ln_b = (const float*)d_in[15];
    p.out = (float*)d_out; p.ws = (unsigned char*)d_ws;
    if (hipMemsetAsync((unsigned char*)d_ws + WS_BAR, 0, (size_t)XCD_BAR_WORDS * 4, stream) != hipSuccess) { fprintf(stderr, "kernel_launch: memset of barrier words failed\n"); return; }
    void* args[] = {&p};
    const hipError_t e = hipLaunchCooperativeKernel((const void*)fwd_megakernel, dim3(grid), dim3(512), args, LDS_BYTES, stream);
    if (e != hipSuccess) fprintf(stderr, "kernel_launch: cooperative launch failed: %s (grid %d)\n", hipGetErrorString(e), grid);
}
```
